# Optimizing an MI355X kernel written in HIP

```python
import jax, jax.numpy as jnp
from jax import lax
import numpy as np

D_MODEL = 1024
BATCH = 8
SEQ = 2048
DEPTH = 1
DEC_BATCH = 128
DEC_SEQ = 8
PAST_LEN = 16384
PAGE_SIZE = 128

MIX_W = D_MODEL
GROUP_W = MIX_W // 2
N_HEADS_A = 8
N_HEADS_B = 8
HEAD_DIM = GROUP_W // N_HEADS_A
K_A = 3
K_B = 31
IN_COLS = 5 * GROUP_W
D_FF = ((8 * D_MODEL // 3 + 255) // 256) * 256
EPS = 1e-6

kernel_name = "hybrid_shortconv_conformer_decode_step"


def rmsnorm(x, g):
    xf = x.astype(jnp.float32)
    r = xf * lax.rsqrt(jnp.mean(xf * xf, axis=-1, keepdims=True) + EPS)
    return (r * g.astype(jnp.float32)).astype(x.dtype)


def layernorm(x, g, b):
    xf = x.astype(jnp.float32)
    mu = jnp.mean(xf, axis=-1, keepdims=True)
    xc = xf - mu
    var = jnp.mean(xc * xc, axis=-1, keepdims=True)
    r = xc * lax.rsqrt(var + EPS) * g.astype(jnp.float32) + b.astype(jnp.float32)
    return r.astype(x.dtype)


def causal_dwconv(u, hist, w):
    k, c = w.shape
    up = jnp.concatenate([hist.astype(u.dtype), u], axis=1)
    y = lax.conv_general_dilated(up, w.astype(u.dtype)[:, None, :], window_strides=(1,),
                                 padding='VALID', dimension_numbers=('NWC', 'WIO', 'NWC'),
                                 feature_group_count=c)
    return y, up[:, up.shape[1] - (k - 1):]


def layer(x, hist_a, hist_b, g_mix, w_in, conv_a_w, conv_b_w, conv_b_bias, ln_b_g, ln_b_b,
          w_out, g_ffn, w_gate, w_up, w_down):
    h = rmsnorm(x, g_mix)
    z = jnp.einsum('btd,dc->btc', h, w_in)
    b_gate, c_gate, v, glu_val, glu_gate = jnp.split(z, 5, axis=-1)
    conv_a, new_a = causal_dwconv(c_gate * v, hist_a, conv_a_w)
    y_a = b_gate * conv_a
    u_b = glu_val * jax.nn.sigmoid(glu_gate)
    conv_b, new_b = causal_dwconv(u_b, hist_b, conv_b_w)
    y_b = jax.nn.silu(layernorm(conv_b + conv_b_bias.astype(conv_b.dtype), ln_b_g, ln_b_b))
    x = x + jnp.einsum('btc,cd->btd', jnp.concatenate([y_a, y_b], axis=-1), w_out)
    h2 = rmsnorm(x, g_ffn)
    f = jax.nn.silu(jnp.einsum('btd,df->btf', h2, w_gate)) * jnp.einsum('btd,df->btf', h2, w_up)
    x = x + jnp.einsum('btf,fd->btd', f, w_down)
    return x, new_a, new_b


def setup_inputs(seed: int = 0) -> dict:
    key = jax.random.key(seed)
    ks = jax.random.split(key, 20)
    f32 = jnp.float32
    nrm = lambda k, s, sc: (jax.random.normal(k, s, f32) * sc).astype(f32)
    return {
        "x_prompt": nrm(ks[0], (BATCH, SEQ, D_MODEL), 1.0),
        "x_sample": nrm(ks[1], (DEC_BATCH, DEC_SEQ, D_MODEL), 1.0),
        "state_conv_a": nrm(ks[2], (DEPTH, DEC_BATCH, K_A - 1, GROUP_W), 1.0),
        "state_conv_b": nrm(ks[3], (DEPTH, DEC_BATCH, K_B - 1, GROUP_W), 1.0),
        "g_mix": 1.0 + nrm(ks[4], (DEPTH, D_MODEL), 0.1),
        "w_in": nrm(ks[5], (DEPTH, D_MODEL, IN_COLS), D_MODEL ** -0.5),
        "conv_a_w": nrm(ks[6], (DEPTH, K_A, GROUP_W), K_A ** -0.5),
        "conv_b_w": nrm(ks[7], (DEPTH, K_B, GROUP_W), K_B ** -0.5),
        "conv_b_bias": nrm(ks[8], (DEPTH, GROUP_W), 0.02),
        "ln_b_g": 1.0 + nrm(ks[9], (DEPTH, GROUP_W), 0.1),
        "ln_b_b": nrm(ks[10], (DEPTH, GROUP_W), 0.02),
        "w_out": nrm(ks[11], (DEPTH, MIX_W, D_MODEL), MIX_W ** -0.5),
        "g_ffn": 1.0 + nrm(ks[12], (DEPTH, D_MODEL), 0.1),
        "w_gate": nrm(ks[13], (DEPTH, D_MODEL, D_FF), D_MODEL ** -0.5),
        "w_up": nrm(ks[14], (DEPTH, D_MODEL, D_FF), D_MODEL ** -0.5),
        "w_down": nrm(ks[15], (DEPTH, D_FF, D_MODEL), D_FF ** -0.5),
        "g_final": 1.0 + nrm(ks[16], (D_MODEL,), 0.1),
    }


def reference(x_prompt, x_sample, state_conv_a, state_conv_b, g_mix, w_in, conv_a_w, conv_b_w,
              conv_b_bias, ln_b_g, ln_b_b, w_out, g_ffn, w_gate, w_up, w_down, g_final):
    xp, xs = x_prompt, x_sample
    bp = x_prompt.shape[0]
    pa, pb, sa, sb = [], [], [], []
    for l in range(DEPTH):
        params = (g_mix[l], w_in[l], conv_a_w[l], conv_b_w[l], conv_b_bias[l], ln_b_g[l], ln_b_b[l],
                  w_out[l], g_ffn[l], w_gate[l], w_up[l], w_down[l])
        za = jnp.zeros((bp, K_A - 1, GROUP_W), xp.dtype)
        zb = jnp.zeros((bp, K_B - 1, GROUP_W), xp.dtype)
        xp, npa, npb = layer(xp, za, zb, *params)
        xs, nsa, nsb = layer(xs, state_conv_a[l], state_conv_b[l], *params)
        pa.append(npa); pb.append(npb); sa.append(nsa); sb.append(nsb)
    y_prompt = rmsnorm(xp, g_final)
    y_sample = rmsnorm(xs, g_final)
    new_conv_a_prompt = jnp.stack(pa, axis=0)
    new_conv_b_prompt = jnp.stack(pb, axis=0)
    new_conv_a_sample = jnp.stack(sa, axis=0)
    new_conv_b_sample = jnp.stack(sb, axis=0)
    return (y_prompt, y_sample, new_conv_a_prompt, new_conv_b_prompt, new_conv_a_sample, new_conv_b_sample)
```

```cpp
#include <hip/hip_runtime.h>
#include <cstdio>

#define LAS __attribute__((address_space(3)))
typedef unsigned short bf16_t;
typedef short bf16x8 __attribute__((ext_vector_type(8)));
typedef float f32x4 __attribute__((ext_vector_type(4)));
typedef float f32x2 __attribute__((ext_vector_type(2)));
typedef unsigned u32x4 __attribute__((ext_vector_type(4)));
typedef unsigned u32x2 __attribute__((ext_vector_type(2)));

constexpr int D = 1024, NP = 16384, NS = 1024, M = NP + NS;
constexpr int GW = 512, INC = 2560, FF = 2816, GU = 2 * FF;
constexpr int SEQ = 2048, NB = 8, DSEQ = 8, DB = 128, KA = 3, KB = 31;
constexpr float EPS = 1e-6f;
constexpr size_t O_Y = 0, O_NAP = (size_t)M * D, O_NBP = O_NAP + (size_t)NB * 2 * GW, O_NAS = O_NBP + (size_t)NB * 30 * GW, O_NBS = O_NAS + (size_t)DB * 2 * GW;
constexpr size_t WS_CTL = 0, CTL_BYTES = 16384;
constexpr size_t WS_WIN = WS_CTL + CTL_BYTES;
constexpr size_t WS_WOUT = WS_WIN + (size_t)INC * D * 2;
constexpr size_t WS_WGU = WS_WOUT + (size_t)D * D * 2;
constexpr size_t WS_WDN = WS_WGU + (size_t)GU * D * 2;
constexpr size_t WS_SS1 = WS_WDN + (size_t)D * FF * 2;
constexpr size_t WS_SS2 = WS_SS1 + (size_t)M * 16 * 4;
constexpr size_t WS_X1B = WS_SS2 + (size_t)M * 16 * 4;
constexpr size_t WS_R1 = WS_X1B + (size_t)M * D * 2;
constexpr size_t WS_H = WS_R1;
constexpr size_t WS_CV = WS_H + (size_t)M * D * 2;
constexpr size_t WS_BG = WS_CV + (size_t)M * GW * 2;
constexpr size_t WS_UB = WS_BG + (size_t)M * GW * 2;
constexpr size_t WS_YM = WS_UB + (size_t)M * GW * 2;
constexpr size_t WS_F = WS_R1;
constexpr size_t WS_END = WS_YM + (size_t)M * D * 2;
static_assert((size_t)M * FF * 2 <= WS_END - WS_R1, "F overlay");
static_assert(WS_END <= (size_t)256 * 1024 * 1024, "workspace");

constexpr int NTHREADS = 512, NWAVES = 8;
constexpr int LDS_BYTES = 144 * 1024, MISC_OFF = LDS_BYTES - 16;
constexpr int U_ROWS = 62, CB_OFF = U_ROWS * GW * 4;
static_assert(CB_OFF + 8 * GW * 4 <= MISC_OFF, "lds");

__device__ __forceinline__ unsigned cvt_pk_bf16(float lo, float hi) { unsigned r; asm volatile("v_cvt_pk_bf16_f32 %0, %1, %2" : "=v"(r) : "v"(lo), "v"(hi)); return r; }
__device__ __forceinline__ float bf_lo(unsigned w) { return __uint_as_float(w << 16); }
__device__ __forceinline__ float bf_hi(unsigned w) { return __uint_as_float(w & 0xffff0000u); }
__device__ __forceinline__ float sigmoidf_(float x) { return __builtin_amdgcn_rcpf(1.0f + __expf(-x)); }
__device__ __forceinline__ float wave_sum(float v) {
#pragma unroll
    for (int o = 1; o < 64; o <<= 1) v += __shfl_xor(v, o);
    return v;
}

#define XB_TMO      128
#define XB_XCNT(j)  (256  + 64 * (j))
#define XB_XSUB(j)  (1280 + 64 * (j))
#define XB_XGEN(j)  (2304 + 64 * (j))
#define XB_TOP      3328
#define XB_TOPGEN   3392
#define XCD_BAR_WORDS 3456
#define XB_SPIN_CAP (1u << 18)
static_assert(XCD_BAR_WORDS * 4 <= CTL_BYTES, "ctl");
__device__ __forceinline__ unsigned xb_ld(unsigned* p)              { return __hip_atomic_load(p, __ATOMIC_RELAXED, __HIP_MEMORY_SCOPE_AGENT); }
__device__ __forceinline__ unsigned xb_add(unsigned* p, unsigned v) { return __hip_atomic_fetch_add(p, v, __ATOMIC_RELAXED, __HIP_MEMORY_SCOPE_AGENT); }
__device__ __forceinline__ unsigned xb_xcc_id() { return (unsigned)__builtin_amdgcn_s_getreg((3 << 11) | 20) & 0xFu; }
#define XB_SPIN(cond, bar) do { unsigned _sp = 0; while (cond) { __builtin_amdgcn_s_sleep(1); \
    if ((++_sp & 255u) == 0u) { if (xb_ld(&(bar)[XB_TMO])) break; if (_sp > XB_SPIN_CAP) { atomicAdd(&(bar)[XB_TMO], 1u); break; } } } } while (0)
struct XcdBarrier { unsigned* bar; unsigned x; volatile LAS unsigned* st; };
__device__ __forceinline__ XcdBarrier xcd_barrier_post(unsigned* bar, volatile LAS unsigned* st) {
    XcdBarrier b; b.bar = bar; b.x = xb_xcc_id(); b.st = st;
    if (threadIdx.x == 0) (void)xb_add(&bar[XB_XCNT(b.x)], 1u);
    return b;
}
__device__ __forceinline__ void xcd_barrier_complete(unsigned* bar, unsigned x, unsigned& nloc, unsigned& nx) {
    const unsigned G = gridDim.x * gridDim.y * gridDim.z;
    unsigned sum, cnt, mine, sp = 0u;
    for (;;) {
        sum = 0u; cnt = 0u; mine = 0u;
#pragma unroll
        for (unsigned j = 0; j < 16; ++j) { const unsigned c = xb_ld(&bar[XB_XCNT(j)]); sum += c; cnt += (c > 0u) ? 1u : 0u; mine = (j == x) ? c : mine; }
        if (sum == G) break;
        __builtin_amdgcn_s_sleep(1);
        if ((++sp & 255u) == 0u) { if (xb_ld(&bar[XB_TMO])) break; if (sp > XB_SPIN_CAP) { atomicAdd(&bar[XB_TMO], 1u); break; } }
    }
    nloc = mine > 0u ? mine : 1u; nx = cnt > 0u ? cnt : 1u;
}
__device__ __forceinline__ void xcd_barrier(const XcdBarrier& b) {
    asm volatile("s_waitcnt vmcnt(0)" ::: "memory");
    __syncthreads();
    if (threadIdx.x == 0) {
        unsigned* bar = b.bar;
        __builtin_amdgcn_s_waitcnt(0);
        unsigned nloc = b.st[0], nx = b.st[1];
        if (nloc == 0u) { xcd_barrier_complete(bar, b.x, nloc, nx); b.st[0] = nloc; b.st[1] = nx; }
        const unsigned old = xb_add(&bar[XB_XSUB(b.x)], 1u);
        const unsigned gen = old / nloc;
        if (old + 1u == (gen + 1u) * nloc) {
            __builtin_amdgcn_fence(__ATOMIC_RELEASE, "agent");
            asm volatile("s_waitcnt vmcnt(0)" ::: "memory");
            const unsigned og = xb_add(&bar[XB_TOP], 1u);
            const unsigned tg = og / nx;
            if (og + 1u == (tg + 1u) * nx) xb_add(&bar[XB_TOPGEN], 1u);
            else XB_SPIN(xb_ld(&bar[XB_TOPGEN]) == tg, bar);
            __builtin_amdgcn_fence(__ATOMIC_ACQUIRE, "agent");
            xb_add(&bar[XB_XGEN(b.x)], 1u);
            asm volatile("s_waitcnt vmcnt(0)" ::: "memory");
        } else {
            XB_SPIN(xb_ld(&bar[XB_XGEN(b.x)]) == gen, bar);
            __builtin_amdgcn_fence(__ATOMIC_ACQUIRE, "agent");
            asm volatile("s_waitcnt vmcnt(0)" ::: "memory");
        }
    }
    __syncthreads();
}

namespace pg8 {
constexpr int BM = 256, BK = 64, HALF = 128, HTB = HALF * BK * 2, STAGE_BYTES = 8 * HTB, NXCD = 8, WGM = 8;
__host__ __device__ __forceinline__ int lds_byte(int r, int c) { const int st = (r >> 4) * 2 + (c >> 5), rr = r & 15, cc = c & 31, ob = rr * 64 + cc * 2; return st * 1024 + (ob ^ (((ob >> 9) & 1) << 5)); }
__host__ __device__ __forceinline__ void stage_rc(int b, int& R, int& C) { const int st = b / 1024, sb = b % 1024, swz = sb ^ (((sb >> 9) & 1) << 5); R = (st >> 1) * 16 + swz / 64; C = (st & 1) * 32 + (swz % 64) / 2; }
__host__ __device__ __forceinline__ int perm32(int rho) { const int n = rho >> 4, i = rho & 15; return 8 * (i >> 2) + 4 * n + (i & 3); }
struct Unit { int pm, pn; };
struct Gemm { const bf16_t* A; const bf16_t* Bt; int M, N, K; };
struct StaticOrder {
    int nM, nN, nwg, G, c;
    __host__ __device__ void init(int M_, int N_, int G_, int c_) { nM = M_ / BM; nN = N_ / BM; nwg = nM * nN; G = G_; c = c_; }
    __host__ __device__ bool next(int i, Unit& u) const {
        const long L = (long)i * G + c; if (L >= nwg) return false;
        int wgid = (int)L; { const int q = nwg / NXCD, r = nwg % NXCD, xcd = wgid % NXCD, off = wgid / NXCD; wgid = (xcd < r ? xcd * (q + 1) : r * (q + 1) + (xcd - r) * q) + off; }
        const int nig = WGM * nN, gid = wgid / nig, fm = gid * WGM, gsz = (nM - fm) < WGM ? (nM - fm) : WGM;
        u.pm = fm + ((wgid % nig) % gsz); u.pn = (wgid % nig) / gsz; return true;
    }
};
template <class Epi>
__device__ __forceinline__ void gemm_phase(LAS unsigned char* lds, const Gemm g, const StaticOrder& S, const Epi& E) {
    const int tid = threadIdx.x, wid = __builtin_amdgcn_readfirstlane(tid >> 6), lane = tid & 63, wr = wid >> 2, wc = wid & 3, fr = lane & 15, fq = lane >> 4;
    const int K = g.K, nt = K / BK;
    unsigned voffA[2], voffB[2];
#pragma unroll
    for (int i = 0; i < 2; ++i) { int R, C; stage_rc(tid * 16 + i * 8192, R, C); const int Rb = Epi::PERM ? ((R & ~31) + perm32(R & 31)) : R;
        voffA[i] = (unsigned)(R * K + C) * 2u; voffB[i] = (unsigned)(Rb * K + C) * 2u; }
    const size_t kstep = (size_t)(BK * 2);
    const size_t hstep = (size_t)HALF * K * 2;
    const size_t tstep = 2 * hstep;
    const unsigned ldsw = (unsigned)wid * 1024u;
    const int aoff = lds_byte(wr * 64 + fr, fq * 8), boff = lds_byte(wc * 32 + fr, fq * 8);
#define PG8_SA(b, h) (((b) * 2 + (h)) * HTB)
#define PG8_SB(b, h) ((4 + (b) * 2 + (h)) * HTB)
#define PG8_STAGE(bufoff, gbase, voff) do { _Pragma("unroll") for (int _i = 0; _i < 2; ++_i) \
        __builtin_amdgcn_global_load_lds((const unsigned*)((const char*)(gbase) + (voff)[_i]), (LAS unsigned*)(lds + (bufoff) + ldsw + _i * 8192), 16, 0, 0); } while (0)
#define PG8_LDA(dst, b, h) do { _Pragma("unroll") for (int m = 0; m < 4; ++m) _Pragma("unroll") for (int k = 0; k < 2; ++k) dst[m][k] = *(const LAS bf16x8*)(lds + PG8_SA(b, h) + aoff + m * 2048 + k * 1024); } while (0)
#define PG8_LDB(dst, b, h) do { _Pragma("unroll") for (int n = 0; n < 2; ++n) _Pragma("unroll") for (int k = 0; k < 2; ++k) dst[n][k] = *(const LAS bf16x8*)(lds + PG8_SB(b, h) + boff + n * 2048 + k * 1024); } while (0)
#define PG8_MMA(ai, bj, At, Bt) do { __builtin_amdgcn_s_setprio(1); _Pragma("unroll") for (int m = 0; m < 4; ++m) _Pragma("unroll") for (int n = 0; n < 2; ++n) _Pragma("unroll") for (int k = 0; k < 2; ++k) \
        acc[ai][bj][m][n] = __builtin_amdgcn_mfma_f32_16x16x32_bf16(Bt[n][k], At[m][k], acc[ai][bj][m][n], 0, 0, 0); __builtin_amdgcn_s_setprio(0); } while (0)
#define PG8_WAIT_V(n) asm volatile("s_waitcnt vmcnt(" #n ")" ::: "memory")
#define PG8_WAIT_L(n) asm volatile("s_waitcnt lgkmcnt(" #n ")" ::: "memory")
#define PG8_BAR __builtin_amdgcn_s_barrier()
#define PG8_SCHED __builtin_amdgcn_sched_barrier(0)
    Unit cur, nxt; int ui = 0;
    if (!S.next(0, cur)) return;
    f32x4 acc[2][2][4][2];
#pragma unroll
    for (int a = 0; a < 2; ++a)
#pragma unroll
        for (int b = 0; b < 2; ++b)
#pragma unroll
            for (int m = 0; m < 4; ++m)
#pragma unroll
                for (int n = 0; n < 2; ++n) acc[a][b][m][n] = (f32x4){0.f, 0.f, 0.f, 0.f};
    bf16x8 At[4][2], B0[2][2], B1[2][2];
    const char* cA = (const char*)g.A + (size_t)cur.pm * tstep; const char* cB = (const char*)g.Bt + (size_t)cur.pn * tstep;
    PG8_STAGE(PG8_SB(0, 0), cB, voffB); PG8_STAGE(PG8_SA(0, 0), cA, voffA); PG8_STAGE(PG8_SB(0, 1), cB + hstep, voffB); PG8_STAGE(PG8_SA(0, 1), cA + hstep, voffA);
    if (wr == 1) PG8_BAR;
    PG8_WAIT_V(4); PG8_BAR;
    PG8_STAGE(PG8_SB(1, 0), cB + kstep, voffB); PG8_STAGE(PG8_SA(1, 0), cA + kstep, voffA); PG8_STAGE(PG8_SB(1, 1), cB + hstep + kstep, voffB);
    PG8_WAIT_V(6); PG8_BAR;
    for (;;) {
        const bool has_next = S.next(ui + 1, nxt);
        const char* nA = has_next ? (const char*)g.A + (size_t)nxt.pm * tstep : cA; const char* nB = has_next ? (const char*)g.Bt + (size_t)nxt.pn * tstep : cB;
        for (int t = 0; t < nt; t += 2) {
            const bool last = (t == nt - 2);
            const char* a1 = cA + (size_t)(t + 1) * kstep;
            const char* a2 = last ? nA : cA + (size_t)(t + 2) * kstep; const char* b2 = last ? nB : cB + (size_t)(t + 2) * kstep;
            const char* a3 = a2 + kstep; const char* b3 = b2 + kstep;
            PG8_LDB(B0, 0, 0); PG8_SCHED; PG8_LDA(At, 0, 0); PG8_STAGE(PG8_SA(1, 1), a1 + hstep, voffA);
            PG8_WAIT_L(8); PG8_BAR; PG8_WAIT_L(0); PG8_MMA(0, 0, At, B0); PG8_BAR; PG8_SCHED;
            PG8_LDB(B1, 0, 1); PG8_STAGE(PG8_SB(0, 0), b2, voffB);
            PG8_BAR; PG8_WAIT_L(0); PG8_MMA(0, 1, At, B1); PG8_BAR;
            PG8_LDA(At, 0, 1); PG8_STAGE(PG8_SA(0, 0), a2, voffA);
            PG8_BAR; PG8_WAIT_L(0); PG8_MMA(1, 0, At, B0); PG8_BAR; PG8_SCHED;
            PG8_STAGE(PG8_SB(0, 1), b2 + hstep, voffB);
            PG8_WAIT_V(6); PG8_BAR; PG8_MMA(1, 1, At, B1); PG8_BAR;
            PG8_LDB(B0, 1, 0); PG8_SCHED; PG8_LDA(At, 1, 0); PG8_STAGE(PG8_SA(0, 1), a2 + hstep, voffA);
            PG8_WAIT_L(8); PG8_BAR; PG8_WAIT_L(0); PG8_MMA(0, 0, At, B0); PG8_BAR; PG8_SCHED;
            PG8_LDB(B1, 1, 1); PG8_STAGE(PG8_SB(1, 0), b3, voffB);
            PG8_BAR; PG8_WAIT_L(0); PG8_MMA(0, 1, At, B1); PG8_BAR;
            PG8_LDA(At, 1, 1); PG8_STAGE(PG8_SA(1, 0), a3, voffA);
            PG8_BAR; PG8_WAIT_L(0); PG8_MMA(1, 0, At, B0); PG8_BAR; PG8_SCHED;
            PG8_STAGE(PG8_SB(1, 1), b3 + hstep, voffB);
            PG8_WAIT_V(6); PG8_BAR; PG8_MMA(1, 1, At, B1); PG8_BAR;
        }
        E(acc, cur, wr, wc, fr, fq);
        if (!has_next) break;
#pragma unroll
        for (int a = 0; a < 2; ++a)
#pragma unroll
            for (int b = 0; b < 2; ++b)
#pragma unroll
                for (int m = 0; m < 4; ++m)
#pragma unroll
                    for (int n = 0; n < 2; ++n) acc[a][b][m][n] = (f32x4){0.f, 0.f, 0.f, 0.f};
        cur = nxt; cA = nA; cB = nB; ++ui;
    }
    PG8_WAIT_V(0);
    if (wr == 0) PG8_BAR;
    PG8_BAR;
#undef PG8_SA
#undef PG8_SB
#undef PG8_STAGE
#undef PG8_LDA
#undef PG8_LDB
#undef PG8_MMA
#undef PG8_WAIT_V
#undef PG8_WAIT_L
#undef PG8_BAR
#undef PG8_SCHED
}
}
using pg8::Unit; using pg8::HALF;

struct EpiIn {
    static constexpr bool PERM = true;
    bf16_t *CV, *BG, *UB;
    __device__ __forceinline__ void operator()(const f32x4 (&acc)[2][2][4][2], const Unit& u, int wr, int wc, int fr, int fq) const {
        const int row0 = u.pm * 256 + wr * 64 + fr;
        if (u.pn == 4 || u.pn == 5) {
            const int col0 = (u.pn - 4) * 256 + wc * 32 + 8 * fq;
#pragma unroll
            for (int ai = 0; ai < 2; ++ai)
#pragma unroll
                for (int m = 0; m < 4; ++m) { bf16_t* rowp = BG + (size_t)(row0 + ai * HALF + m * 16) * GW + col0;
#pragma unroll
                    for (int bj = 0; bj < 2; ++bj) { const f32x4 v0 = acc[ai][bj][m][0], v1 = acc[ai][bj][m][1];
                        u32x4 w; w.x = cvt_pk_bf16(v0[0], v0[1]); w.y = cvt_pk_bf16(v0[2], v0[3]); w.z = cvt_pk_bf16(v1[0], v1[1]); w.w = cvt_pk_bf16(v1[2], v1[3]);
                        *(u32x4*)(rowp + bj * HALF) = w; } }
        } else {
            const bool glu = u.pn >= 6; bf16_t* base = glu ? UB : CV; const int pq = glu ? u.pn - 6 : u.pn;
            const int col0 = pq * 128 + wc * 32 + 8 * fq;
#pragma unroll
            for (int ai = 0; ai < 2; ++ai)
#pragma unroll
                for (int m = 0; m < 4; ++m) { bf16_t* rowp = base + (size_t)(row0 + ai * HALF + m * 16) * GW + col0;
                    float o[8];
#pragma unroll
                    for (int n = 0; n < 2; ++n)
#pragma unroll
                        for (int j = 0; j < 4; ++j) { const float a = acc[ai][0][m][n][j], gt = acc[ai][1][m][n][j]; o[n * 4 + j] = glu ? a * sigmoidf_(gt) : a * gt; }
                    u32x4 w; w.x = cvt_pk_bf16(o[0], o[1]); w.y = cvt_pk_bf16(o[2], o[3]); w.z = cvt_pk_bf16(o[4], o[5]); w.w = cvt_pk_bf16(o[6], o[7]);
                    *(u32x4*)rowp = w; }
        }
    }
};
struct EpiOut {
    static constexpr bool PERM = true;
    const float *xp, *xs; bf16_t* X1B; float* SS;
    __device__ __forceinline__ void operator()(const f32x4 (&acc)[2][2][4][2], const Unit& u, int wr, int wc, int fr, int fq) const {
        const int row0 = u.pm * 256 + wr * 64 + fr, col0 = u.pn * 256 + wc * 32 + 8 * fq;
        const float* xb = (u.pm < NP / 256) ? xp : xs - (size_t)NP * D;
#pragma unroll
        for (int ai = 0; ai < 2; ++ai)
#pragma unroll
            for (int m = 0; m < 4; ++m) { const int row = row0 + ai * HALF + m * 16; const float* xr = xb + (size_t)row * D + col0; bf16_t* orow = X1B + (size_t)row * D + col0;
                float ss = 0.f;
#pragma unroll
                for (int bj = 0; bj < 2; ++bj) { const f32x4 x0 = *(const f32x4*)(xr + bj * HALF), x1 = *(const f32x4*)(xr + bj * HALF + 4);
                    const f32x4 v0 = acc[ai][bj][m][0] + x0, v1 = acc[ai][bj][m][1] + x1;
                    ss += (v0[0] * v0[0] + v0[1] * v0[1]) + (v0[2] * v0[2] + v0[3] * v0[3]) + (v1[0] * v1[0] + v1[1] * v1[1]) + (v1[2] * v1[2] + v1[3] * v1[3]);
                    u32x4 w; w.x = cvt_pk_bf16(v0[0], v0[1]); w.y = cvt_pk_bf16(v0[2], v0[3]); w.z = cvt_pk_bf16(v1[0], v1[1]); w.w = cvt_pk_bf16(v1[2], v1[3]);
                    *(u32x4*)(orow + bj * HALF) = w; }
                ss += __shfl_xor(ss, 16); ss += __shfl_xor(ss, 32);
                if (fq == 0) SS[(size_t)row * 16 + u.pn * 4 + wc] = ss;
                asm volatile("" ::: "memory"); }
    }
};
struct EpiGU {
    static constexpr bool PERM = true;
    const float* SS; bf16_t* F;
    __device__ __forceinline__ void operator()(const f32x4 (&acc)[2][2][4][2], const Unit& u, int wr, int wc, int fr, int fq) const {
        const int row0 = u.pm * 256 + wr * 64 + fr, col0 = u.pn * 128 + wc * 32 + 8 * fq;
#pragma unroll
        for (int ai = 0; ai < 2; ++ai)
#pragma unroll
            for (int m = 0; m < 4; ++m) { const int row = row0 + ai * HALF + m * 16; const f32x4* sp = (const f32x4*)(SS + (size_t)row * 16);
                const f32x4 s0 = sp[0], s1 = sp[1], s2 = sp[2], s3 = sp[3]; const f32x4 st = (s0 + s1) + (s2 + s3);
                const float r = __builtin_amdgcn_rsqf(((st[0] + st[1]) + (st[2] + st[3])) * (1.0f / D) + EPS);
                float o[8];
#pragma unroll
                for (int n = 0; n < 2; ++n)
#pragma unroll
                    for (int j = 0; j < 4; ++j) { const float gt = acc[ai][0][m][n][j] * r, up = acc[ai][1][m][n][j] * r; o[n * 4 + j] = gt * sigmoidf_(gt) * up; }
                u32x4 w; w.x = cvt_pk_bf16(o[0], o[1]); w.y = cvt_pk_bf16(o[2], o[3]); w.z = cvt_pk_bf16(o[4], o[5]); w.w = cvt_pk_bf16(o[6], o[7]);
                *(u32x4*)(F + (size_t)row * FF + col0) = w; }
    }
};
struct EpiDown {
    static constexpr bool PERM = true;
    const bf16_t* X1B; float* Y; float* SS;
    __device__ __forceinline__ void operator()(const f32x4 (&acc)[2][2][4][2], const Unit& u, int wr, int wc, int fr, int fq) const {
        const int row0 = u.pm * 256 + wr * 64 + fr, col0 = u.pn * 256 + wc * 32 + 8 * fq;
#pragma unroll
        for (int ai = 0; ai < 2; ++ai)
#pragma unroll
            for (int m = 0; m < 4; ++m) { const int row = row0 + ai * HALF + m * 16; const bf16_t* xr = X1B + (size_t)row * D + col0; float* orow = Y + (size_t)row * D + col0;
                float ss = 0.f;
#pragma unroll
                for (int bj = 0; bj < 2; ++bj) { const u32x4 xw = *(const u32x4*)(xr + bj * HALF);
                    const f32x4 x0 = {bf_lo(xw.x), bf_hi(xw.x), bf_lo(xw.y), bf_hi(xw.y)}, x1 = {bf_lo(xw.z), bf_hi(xw.z), bf_lo(xw.w), bf_hi(xw.w)};
                    const f32x4 v0 = acc[ai][bj][m][0] + x0, v1 = acc[ai][bj][m][1] + x1;
                    ss += (v0[0] * v0[0] + v0[1] * v0[1]) + (v0[2] * v0[2] + v0[3] * v0[3]) + (v1[0] * v1[0] + v1[1] * v1[1]) + (v1[2] * v1[2] + v1[3] * v1[3]);
                    *(f32x4*)(orow + bj * HALF) = v0; *(f32x4*)(orow + bj * HALF + 4) = v1; }
                ss += __shfl_xor(ss, 16); ss += __shfl_xor(ss, 32);
                if (fq == 0) SS[(size_t)row * 16 + u.pn * 4 + wc] = ss;
                asm volatile("" ::: "memory"); }
    }
};

struct Args {
    const float* in[17];
    float* out; unsigned char* ws;
};

__device__ __forceinline__ void p0_transpose_item(const float* W, int ldw, int col0, int k0, bf16_t* WT, int K, int drow0, const float* kscale, LAS float* scr, int lane) {
#pragma unroll 8
    for (int i = 0; i < 32; ++i) { const int kk = 2 * i + (lane >> 5); float v = W[(size_t)(k0 + kk) * ldw + col0 + (lane & 31)]; if (kscale) v *= kscale[k0 + kk]; scr[kk * 33 + (lane & 31)] = v; }
    asm volatile("s_waitcnt lgkmcnt(0)" ::: "memory");
    const int c = lane & 7;
#pragma unroll
    for (int j = 0; j < 4; ++j) { const int n = (lane >> 3) + 8 * j; const LAS float* s = scr + (8 * c) * 33 + n;
        u32x4 o; o.x = cvt_pk_bf16(s[0 * 33], s[1 * 33]); o.y = cvt_pk_bf16(s[2 * 33], s[3 * 33]); o.z = cvt_pk_bf16(s[4 * 33], s[5 * 33]); o.w = cvt_pk_bf16(s[6 * 33], s[7 * 33]);
        *(u32x4*)(WT + (size_t)(drow0 + n) * K + k0 + 8 * c) = o; }
    asm volatile("s_waitcnt lgkmcnt(0)" ::: "memory");
}
__device__ __forceinline__ const float* xrow_ptr(const float* xp, const float* xs, int m) { return m < NP ? xp + (size_t)m * D : xs + (size_t)(m - NP) * D; }

__device__ __forceinline__ void phase0(const Args& a, LAS unsigned char* lds, int wave, int lane) {
    LAS float* scr = (LAS float*)(lds + wave * 16384);
    const int gw = blockIdx.x * NWAVES + wave, NGW = gridDim.x * NWAVES;
    const float *w_in = a.in[5], *w_out = a.in[11], *g_ffn = a.in[12], *w_gate = a.in[13], *w_up = a.in[14], *w_down = a.in[15];
    bf16_t* WIN = (bf16_t*)(a.ws + WS_WIN); bf16_t* WOUT = (bf16_t*)(a.ws + WS_WOUT); bf16_t* WGU = (bf16_t*)(a.ws + WS_WGU); bf16_t* WDN = (bf16_t*)(a.ws + WS_WDN);
    constexpr int I_IN = (D / 64) * (INC / 32), I_OUT = (D / 64) * (D / 32), I_GU = (D / 64) * (GU / 32), I_DN = (FF / 64) * (D / 32);
    constexpr int NITEMS = I_IN + I_OUT + I_GU + I_DN;
    for (int it = gw; it < NITEMS; it += NGW) {
        int r = it;
        if (r < I_IN) { const int nblk = INC / 32, kb = r / nblk, R0 = (r % nblk) * 32;
            int col;
            if (R0 < 1024) { const int pn = R0 >> 8, w = R0 & 255; col = ((w < 128) ? 512 : 1024) + 128 * pn + (w & 127); }
            else if (R0 < 1536) col = R0 - 1024;
            else { const int q = R0 - 1536, pn = q >> 8, w = q & 255; col = ((w < 128) ? 1536 : 2048) + 128 * pn + (w & 127); }
            p0_transpose_item(w_in, INC, col, kb * 64, WIN, D, R0, nullptr, scr, lane); continue; }
        r -= I_IN;
        if (r < I_OUT) { const int nblk = D / 32, kb = r / nblk, R0 = (r % nblk) * 32; p0_transpose_item(w_out, D, R0, kb * 64, WOUT, D, R0, nullptr, scr, lane); continue; }
        r -= I_OUT;
        if (r < I_GU) { const int nblk = GU / 32, kb = r / nblk, R0 = (r % nblk) * 32; const int pn = R0 >> 8, w = R0 & 255;
            p0_transpose_item((w < 128) ? w_gate : w_up, FF, 128 * pn + (w & 127), kb * 64, WGU, D, R0, g_ffn, scr, lane); continue; }
        r -= I_GU;
        { const int nblk = D / 32, kb = r / nblk, R0 = (r % nblk) * 32; p0_transpose_item(w_down, D, R0, kb * 64, WDN, FF, R0, nullptr, scr, lane); }
    }
    const float* g_mix = a.in[4]; bf16_t* H = (bf16_t*)(a.ws + WS_H);
    f32x4 gm[4];
#pragma unroll
    for (int j = 0; j < 4; ++j) gm[j] = ((const f32x4*)g_mix)[lane + 64 * j];
    for (int m = gw; m < M; m += NGW) {
        const f32x4* xr = (const f32x4*)xrow_ptr(a.in[0], a.in[1], m) + lane;
        f32x4 v[4]; float s = 0.f;
#pragma unroll
        for (int j = 0; j < 4; ++j) { v[j] = xr[64 * j]; s += (v[j].x * v[j].x + v[j].y * v[j].y) + (v[j].z * v[j].z + v[j].w * v[j].w); }
        const float r = __builtin_amdgcn_rsqf(wave_sum(s) * (1.f / D) + EPS);
        u32x2* o8 = (u32x2*)(H + (size_t)m * D) + lane;
#pragma unroll
        for (int j = 0; j < 4; ++j) { u32x2 w; w.x = cvt_pk_bf16(v[j].x * r * gm[j].x, v[j].y * r * gm[j].y); w.y = cvt_pk_bf16(v[j].z * r * gm[j].z, v[j].w * r * gm[j].w); o8[64 * j] = w; }
    }
}

__device__ __forceinline__ void load8_bf16(const bf16_t* p, float (&v)[8]) {
    const u32x4 w = *(const u32x4*)p;
    v[0] = bf_lo(w.x); v[1] = bf_hi(w.x); v[2] = bf_lo(w.y); v[3] = bf_hi(w.y); v[4] = bf_lo(w.z); v[5] = bf_hi(w.z); v[6] = bf_lo(w.w); v[7] = bf_hi(w.w);
}
__device__ __forceinline__ void load8_f32(const float* p, float (&v)[8]) {
    const f32x4 a = *(const f32x4*)p, b = *(const f32x4*)(p + 4);
    v[0] = a.x; v[1] = a.y; v[2] = a.z; v[3] = a.w; v[4] = b.x; v[5] = b.y; v[6] = b.z; v[7] = b.w;
}
__device__ __forceinline__ void store8_f32(float* p, const float (&v)[8]) {
    *(f32x4*)p = (f32x4){v[0], v[1], v[2], v[3]}; *(f32x4*)(p + 4) = (f32x4){v[4], v[5], v[6], v[7]};
}
__device__ __forceinline__ void phase_conv(const Args& a, LAS unsigned char* lds, int wave, int lane) {
    const int tid = threadIdx.x;
    const float *state_a = a.in[2], *state_b = a.in[3], *conv_a_w = a.in[6], *conv_b_w = a.in[7], *conv_b_bias = a.in[8], *ln_g = a.in[9], *ln_b = a.in[10];
    const bf16_t* CV = (const bf16_t*)(a.ws + WS_CV); const bf16_t* BG = (const bf16_t*)(a.ws + WS_BG); const bf16_t* UB = (const bf16_t*)(a.ws + WS_UB);
    bf16_t* YM = (bf16_t*)(a.ws + WS_YM);
    LAS float* U = (LAS float*)lds; LAS float* CB = (LAS float*)(lds + CB_OFF);
    float wb[KB];
#pragma unroll
    for (int k = 0; k < KB; ++k) wb[k] = conv_b_w[k * GW + tid];
    const float bias = conv_b_bias[tid];
    const int c8 = (tid & 63) * 8, rsub = tid >> 6;
    for (int item = blockIdx.x; item < 640; item += gridDim.x) {
        int T, row0, pos0, L, seq; bool smp;
        if (item < 512) { seq = item >> 6; T = 32; pos0 = (item & 63) * 32; row0 = seq * SEQ + pos0; L = SEQ; smp = false; }
        else { seq = item - 512; T = 8; pos0 = 0; row0 = NP + seq * DSEQ; L = DSEQ; smp = true; }
        for (int s = rsub; s < T + 30; s += 8) { const int ts = pos0 - 30 + s; float v[8];
            if (ts >= 0) load8_bf16(UB + (size_t)(row0 - pos0 + ts) * GW + c8, v);
            else if (smp) load8_f32(state_b + ((size_t)seq * 30 + (30 + ts)) * GW + c8, v);
            else {
#pragma unroll
                for (int j = 0; j < 8; ++j) v[j] = 0.f; }
            *(LAS f32x4*)(U + s * GW + c8) = (f32x4){v[0], v[1], v[2], v[3]}; *(LAS f32x4*)(U + s * GW + c8 + 4) = (f32x4){v[4], v[5], v[6], v[7]}; }
        { float w0[8], w1[8], w2[8]; load8_f32(conv_a_w + c8, w0); load8_f32(conv_a_w + GW + c8, w1); load8_f32(conv_a_w + 2 * GW + c8, w2);
          for (int t = rsub; t < T; t += 8) { const int pos = pos0 + t, row = row0 + t; float c0[8], c1[8], c2[8], bg[8];
              load8_bf16(CV + (size_t)row * GW + c8, c0); load8_bf16(BG + (size_t)row * GW + c8, bg);
              if (pos >= 1) load8_bf16(CV + (size_t)(row - 1) * GW + c8, c1);
              else if (smp) load8_f32(state_a + ((size_t)seq * 2 + 1) * GW + c8, c1);
              else {
#pragma unroll
                  for (int j = 0; j < 8; ++j) c1[j] = 0.f; }
              if (pos >= 2) load8_bf16(CV + (size_t)(row - 2) * GW + c8, c2);
              else if (smp) load8_f32(state_a + ((size_t)seq * 2 + pos) * GW + c8, c2);
              else {
#pragma unroll
                  for (int j = 0; j < 8; ++j) c2[j] = 0.f; }
              float y[8];
#pragma unroll
              for (int j = 0; j < 8; ++j) y[j] = bg[j] * (w0[j] * c2[j] + w1[j] * c1[j] + w2[j] * c0[j]);
              u32x4 w; w.x = cvt_pk_bf16(y[0], y[1]); w.y = cvt_pk_bf16(y[2], y[3]); w.z = cvt_pk_bf16(y[4], y[5]); w.w = cvt_pk_bf16(y[6], y[7]);
              *(u32x4*)(YM + (size_t)row * D + c8) = w;
              if (pos >= L - 2) store8_f32(a.out + (smp ? O_NAS : O_NAP) + ((size_t)seq * 2 + (pos - (L - 2))) * GW + c8, c0);
          } }
        __syncthreads();
        for (int g = 0; g < T / 8; ++g) {
            float acc[8];
#pragma unroll
            for (int o = 0; o < 8; ++o) acc[o] = bias;
#pragma unroll
            for (int j = 0; j < 38; ++j) { const float v = U[(8 * g + j) * GW + tid];
#pragma unroll
                for (int o = 0; o < 8; ++o) { const int k = j - o; if (k >= 0 && k < KB) acc[o] += wb[k] * v; } }
#pragma unroll
            for (int o = 0; o < 8; ++o) CB[o * GW + tid] = acc[o];
            __syncthreads();
            { const f32x4 xa = *(const LAS f32x4*)(CB + wave * GW + lane * 8), xb = *(const LAS f32x4*)(CB + wave * GW + lane * 8 + 4);
              float x[8] = {xa.x, xa.y, xa.z, xa.w, xb.x, xb.y, xb.z, xb.w};
              float s = 0.f;
#pragma unroll
              for (int j = 0; j < 8; ++j) s += x[j];
              const float mean = wave_sum(s) * (1.f / GW); float q = 0.f;
#pragma unroll
              for (int j = 0; j < 8; ++j) { x[j] -= mean; q += x[j] * x[j]; }
              const float rstd = __builtin_amdgcn_rsqf(wave_sum(q) * (1.f / GW) + EPS);
              float gg[8], bb[8]; load8_f32(ln_g + lane * 8, gg); load8_f32(ln_b + lane * 8, bb);
              float y[8];
#pragma unroll
              for (int j = 0; j < 8; ++j) { const float z = x[j] * rstd * gg[j] + bb[j]; y[j] = z * sigmoidf_(z); }
              u32x4 w; w.x = cvt_pk_bf16(y[0], y[1]); w.y = cvt_pk_bf16(y[2], y[3]); w.z = cvt_pk_bf16(y[4], y[5]); w.w = cvt_pk_bf16(y[6], y[7]);
              *(u32x4*)(YM + (size_t)(row0 + 8 * g + wave) * D + GW + lane * 8) = w; }
            __syncthreads();
        }
        if (pos0 + T == L) {
            float* nb = a.out + (smp ? O_NBS : O_NBP) + (size_t)seq * 30 * GW;
            for (int i = rsub; i < 30; i += 8) { const f32x4 p = *(const LAS f32x4*)(U + (T + i) * GW + c8), q = *(const LAS f32x4*)(U + (T + i) * GW + c8 + 4);
                *(f32x4*)(nb + (size_t)i * GW + c8) = p; *(f32x4*)(nb + (size_t)i * GW + c8 + 4) = q; }
        }
        __syncthreads();
    }
}

__device__ __forceinline__ void phase_final(const Args& a, int wave, int lane) {
    const int gw = blockIdx.x * NWAVES + wave, NGW = gridDim.x * NWAVES;
    const float* g_final = a.in[16]; const float* SS2 = (const float*)(a.ws + WS_SS2);
    f32x4 gf[4];
#pragma unroll
    for (int j = 0; j < 4; ++j) gf[j] = ((const f32x4*)g_final)[lane + 64 * j];
    for (int m = gw; m < M; m += NGW) {
        const float sp = (lane < 16) ? SS2[(size_t)m * 16 + lane] : 0.f;
        const float r = __builtin_amdgcn_rsqf(wave_sum(sp) * (1.f / D) + EPS);
        f32x4* yr = (f32x4*)(a.out + O_Y + (size_t)m * D) + lane;
#pragma unroll
        for (int j = 0; j < 4; ++j) { f32x4 v = yr[64 * j]; v = v * r * gf[j]; yr[64 * j] = v; }
    }
}

__global__ void __launch_bounds__(NTHREADS, 2) fwd_megakernel(Args a) {
    extern __shared__ __attribute__((aligned(16))) unsigned char lds_raw[];
    LAS unsigned char* lds = (LAS unsigned char*)lds_raw;
    const int tid = threadIdx.x, lane = tid & 63, wave = __builtin_amdgcn_readfirstlane(tid >> 6);
    volatile LAS unsigned* misc = (volatile LAS unsigned*)(lds + MISC_OFF);
    if (tid < 4) misc[tid] = 0u;
    __syncthreads();
    XcdBarrier bar = xcd_barrier_post((unsigned*)(a.ws + WS_CTL), misc);

    phase0(a, lds, wave, lane);
    xcd_barrier(bar);
    {
        pg8::Gemm g{(const bf16_t*)(a.ws + WS_H), (const bf16_t*)(a.ws + WS_WIN), M, INC, D}; pg8::StaticOrder S; S.init(M, INC, gridDim.x, blockIdx.x);
        EpiIn E{(bf16_t*)(a.ws + WS_CV), (bf16_t*)(a.ws + WS_BG), (bf16_t*)(a.ws + WS_UB)};
        pg8::gemm_phase<EpiIn>(lds, g, S, E);
    }
    xcd_barrier(bar);
    phase_conv(a, lds, wave, lane);
    xcd_barrier(bar);
    {
        pg8::Gemm g{(const bf16_t*)(a.ws + WS_YM), (const bf16_t*)(a.ws + WS_WOUT), M, D, D}; pg8::StaticOrder S; S.init(M, D, gridDim.x, blockIdx.x);
        EpiOut E{a.in[0], a.in[1], (bf16_t*)(a.ws + WS_X1B), (float*)(a.ws + WS_SS1)};
        pg8::gemm_phase<EpiOut>(lds, g, S, E);
    }
    xcd_barrier(bar);
    {
        pg8::Gemm g{(const bf16_t*)(a.ws + WS_X1B), (const bf16_t*)(a.ws + WS_WGU), M, GU, D}; pg8::StaticOrder S; S.init(M, GU, gridDim.x, blockIdx.x);
        EpiGU E{(const float*)(a.ws + WS_SS1), (bf16_t*)(a.ws + WS_F)};
        pg8::gemm_phase<EpiGU>(lds, g, S, E);
    }
    xcd_barrier(bar);
    {
        pg8::Gemm g{(const bf16_t*)(a.ws + WS_F), (const bf16_t*)(a.ws + WS_WDN), M, D, FF}; pg8::StaticOrder S; S.init(M, D, gridDim.x, blockIdx.x);
        EpiDown E{(const bf16_t*)(a.ws + WS_X1B), a.out + O_Y, (float*)(a.ws + WS_SS2)};
        pg8::gemm_phase<EpiDown>(lds, g, S, E);
    }
    xcd_barrier(bar);
    phase_final(a, wave, lane);
}

extern "C" void kernel_launch(void* const* d_in, const int* in_sizes, int n_in, void* d_out, int out_size, void* d_ws, size_t ws_size, hipStream_t stream) {
    static int grid = 0;
    if (grid == 0) {
        if (n_in != 17 || ws_size < WS_END) { fprintf(stderr, "kernel_launch: unexpected n_in %d / ws %zu\n", n_in, ws_size); grid = -1; return; }
        int dev = 0, cus = 0, per_cu = 0;
        if (hipGetDevice(&dev) != hipSuccess || hipDeviceGetAttribute(&cus, hipDeviceAttributeMultiprocessorCount, dev) != hipSuccess) { grid = -1; return; }
        if (hipFuncSetAttribute((const void*)fwd_megakernel, hipFuncAttributeMaxDynamicSharedMemorySize, LDS_BYTES) != hipSuccess) { fprintf(stderr, "kernel_launch: hipFuncSetAttribute failed\n"); grid = -1; return; }
        if (hipOccupancyMaxActiveBlocksPerMultiprocessor(&per_cu, (const void*)fwd_megakernel, NTHREADS, LDS_BYTES) != hipSuccess || per_cu < 1) { fprintf(stderr, "kernel_launch: occupancy query says %d blocks per CU\n", per_cu); grid = -1; (void)hipGetLastError(); return; }
        grid = cus;
    }
    if (grid < 0) return;
    (void)hipMemsetAsync((char*)d_ws + WS_CTL, 0, CTL_BYTES, stream);
    Args a{};
    for (int i = 0; i < 17; ++i) a.in[i] = (const float*)d_in[i];
    a.out = (float*)d_out; a.ws = (unsigned char*)d_ws;
    hipLaunchKernelGGL(fwd_megakernel, dim3(grid), dim3(NTHREADS), LDS_BYTES, stream, a);
}
```

```cpp
#include <hip/hip_runtime.h>
#include <cstdio>

#define LAS __attribute__((address_space(3)))
#define REP_P0 1
#define REP_PB 1
#define REP_GA 1
#define REP_GC 1
#define REP_GD 1
#define REP_GE 1
typedef unsigned short bf16_t;
typedef short bf16x8 __attribute__((ext_vector_type(8)));
typedef float f32x4 __attribute__((ext_vector_type(4)));
typedef float f32x2 __attribute__((ext_vector_type(2)));
typedef unsigned u32x4 __attribute__((ext_vector_type(4)));
typedef unsigned u32x2 __attribute__((ext_vector_type(2)));

constexpr int D = 1024, NP = 16384, NS = 1024, M = NP + NS;
constexpr int GW = 512, INC = 2560, FF = 2816, GU = 2 * FF;
constexpr int SEQ = 2048, NB = 8, DSEQ = 8, DB = 128, KA = 3, KB = 31;
constexpr float EPS = 1e-6f;
constexpr size_t O_Y = 0, O_NAP = (size_t)M * D, O_NBP = O_NAP + (size_t)NB * 2 * GW, O_NAS = O_NBP + (size_t)NB * 30 * GW, O_NBS = O_NAS + (size_t)DB * 2 * GW;
constexpr size_t WS_CTL = 0, CTL_BYTES = 16384;
constexpr size_t WS_WIN = WS_CTL + CTL_BYTES;
constexpr size_t WS_WOUT = WS_WIN + (size_t)INC * D * 2;
constexpr size_t WS_WGU = WS_WOUT + (size_t)D * D * 2;
constexpr size_t WS_WDN = WS_WGU + (size_t)GU * D * 2;
constexpr size_t WS_SS1 = WS_WDN + (size_t)D * FF * 2;
constexpr size_t WS_X1B = WS_SS1 + (size_t)M * 16 * 4;
constexpr size_t WS_R1 = WS_X1B + (size_t)M * D * 2;
constexpr size_t WS_H = WS_R1;
constexpr size_t WS_CV = WS_H + (size_t)M * D * 2;
constexpr size_t WS_BG = WS_CV + (size_t)M * GW * 2;
constexpr size_t WS_UB = WS_BG + (size_t)M * GW * 2;
constexpr size_t WS_YM = WS_UB + (size_t)M * GW * 2;
constexpr size_t WS_F = WS_R1;
constexpr size_t WS_SLAB = WS_YM + (size_t)M * D * 2;
constexpr size_t WS_END = WS_SLAB + (size_t)11 * NS * D * 4;
static_assert((size_t)M * FF * 2 <= WS_SLAB - WS_R1, "F overlay");
static_assert((FF / 64) % 4 == 0 && (FF / 64) / 4 == 11, "slab count");
static_assert(WS_END <= (size_t)256 * 1024 * 1024, "workspace");

constexpr int NTHREADS = 512, NWAVES = 8;
constexpr int LDS_BYTES = 144 * 1024, MISC_OFF = LDS_BYTES - 16;
constexpr int U_ROWS = 62, CB_OFF = U_ROWS * GW * 4;
static_assert(CB_OFF + 8 * GW * 4 <= MISC_OFF, "lds");

__device__ __forceinline__ unsigned cvt_pk_bf16(float lo, float hi) { unsigned r; asm volatile("v_cvt_pk_bf16_f32 %0, %1, %2" : "=v"(r) : "v"(lo), "v"(hi)); return r; }
__device__ __forceinline__ float bf_lo(unsigned w) { return __uint_as_float(w << 16); }
__device__ __forceinline__ float bf_hi(unsigned w) { return __uint_as_float(w & 0xffff0000u); }
__device__ __forceinline__ float sigmoidf_(float x) { return __builtin_amdgcn_rcpf(1.0f + __expf(-x)); }
__device__ __forceinline__ float wave_sum(float v) {
#pragma unroll
    for (int o = 1; o < 64; o <<= 1) v += __shfl_xor(v, o);
    return v;
}

#define XB_TMO      128
#define XB_XCNT(j)  (256  + 64 * (j))
#define XB_XSUB(j)  (1280 + 64 * (j))
#define XB_XGEN(j)  (2304 + 64 * (j))
#define XB_TOP      3328
#define XB_TOPGEN   3392
#define XCD_BAR_WORDS 3456
#define XB_SPIN_CAP (1u << 18)
static_assert(XCD_BAR_WORDS * 4 <= CTL_BYTES, "ctl");
__device__ __forceinline__ unsigned xb_ld(unsigned* p)              { return __hip_atomic_load(p, __ATOMIC_RELAXED, __HIP_MEMORY_SCOPE_AGENT); }
__device__ __forceinline__ unsigned xb_add(unsigned* p, unsigned v) { return __hip_atomic_fetch_add(p, v, __ATOMIC_RELAXED, __HIP_MEMORY_SCOPE_AGENT); }
__device__ __forceinline__ unsigned xb_xcc_id() { return (unsigned)__builtin_amdgcn_s_getreg((3 << 11) | 20) & 0xFu; }
#define XB_SPIN(cond, bar) do { unsigned _sp = 0; while (cond) { __builtin_amdgcn_s_sleep(1); \
    if ((++_sp & 255u) == 0u) { if (xb_ld(&(bar)[XB_TMO])) break; if (_sp > XB_SPIN_CAP) { atomicAdd(&(bar)[XB_TMO], 1u); break; } } } } while (0)
struct XcdBarrier { unsigned* bar; unsigned x; volatile LAS unsigned* st; };
__device__ __forceinline__ XcdBarrier xcd_barrier_post(unsigned* bar, volatile LAS unsigned* st) {
    XcdBarrier b; b.bar = bar; b.x = xb_xcc_id(); b.st = st;
    if (threadIdx.x == 0) (void)xb_add(&bar[XB_XCNT(b.x)], 1u);
    return b;
}
__device__ __forceinline__ void xcd_barrier_complete(unsigned* bar, unsigned x, unsigned& nloc, unsigned& nx) {
    const unsigned G = gridDim.x * gridDim.y * gridDim.z;
    unsigned sum, cnt, mine, sp = 0u;
    for (;;) {
        sum = 0u; cnt = 0u; mine = 0u;
#pragma unroll
        for (unsigned j = 0; j < 16; ++j) { const unsigned c = xb_ld(&bar[XB_XCNT(j)]); sum += c; cnt += (c > 0u) ? 1u : 0u; mine = (j == x) ? c : mine; }
        if (sum == G) break;
        __builtin_amdgcn_s_sleep(1);
        if ((++sp & 255u) == 0u) { if (xb_ld(&bar[XB_TMO])) break; if (sp > XB_SPIN_CAP) { atomicAdd(&bar[XB_TMO], 1u); break; } }
    }
    nloc = mine > 0u ? mine : 1u; nx = cnt > 0u ? cnt : 1u;
}
__device__ __forceinline__ void xcd_barrier(const XcdBarrier& b) {
    asm volatile("s_waitcnt vmcnt(0)" ::: "memory");
    __syncthreads();
    if (threadIdx.x == 0) {
        unsigned* bar = b.bar;
        __builtin_amdgcn_s_waitcnt(0);
        unsigned nloc = b.st[0], nx = b.st[1];
        if (nloc == 0u) { xcd_barrier_complete(bar, b.x, nloc, nx); b.st[0] = nloc; b.st[1] = nx; }
        const unsigned old = xb_add(&bar[XB_XSUB(b.x)], 1u);
        const unsigned gen = old / nloc;
        if (old + 1u == (gen + 1u) * nloc) {
            __builtin_amdgcn_fence(__ATOMIC_RELEASE, "agent");
            asm volatile("s_waitcnt vmcnt(0)" ::: "memory");
            const unsigned og = xb_add(&bar[XB_TOP], 1u);
            const unsigned tg = og / nx;
            if (og + 1u == (tg + 1u) * nx) xb_add(&bar[XB_TOPGEN], 1u);
            else XB_SPIN(xb_ld(&bar[XB_TOPGEN]) == tg, bar);
            __builtin_amdgcn_fence(__ATOMIC_ACQUIRE, "agent");
            xb_add(&bar[XB_XGEN(b.x)], 1u);
            asm volatile("s_waitcnt vmcnt(0)" ::: "memory");
        } else {
            XB_SPIN(xb_ld(&bar[XB_XGEN(b.x)]) == gen, bar);
            __builtin_amdgcn_fence(__ATOMIC_ACQUIRE, "agent");
            asm volatile("s_waitcnt vmcnt(0)" ::: "memory");
        }
    }
    __syncthreads();
}

namespace pg8 {
constexpr int BM = 256, BK = 64, HALF = 128, HTB = HALF * BK * 2, STAGE_BYTES = 8 * HTB, NXCD = 8, WGM = 8;
__host__ __device__ __forceinline__ int lds_byte(int r, int c) { const int st = (r >> 4) * 2 + (c >> 5), rr = r & 15, cc = c & 31, ob = rr * 64 + cc * 2; return st * 1024 + (ob ^ (((ob >> 9) & 1) << 5)); }
__host__ __device__ __forceinline__ void stage_rc(int b, int& R, int& C) { const int st = b / 1024, sb = b % 1024, swz = sb ^ (((sb >> 9) & 1) << 5); R = (st >> 1) * 16 + swz / 64; C = (st & 1) * 32 + (swz % 64) / 2; }
__host__ __device__ __forceinline__ int perm32(int rho) { const int n = rho >> 4, i = rho & 15; return 8 * (i >> 2) + 4 * n + (i & 3); }
struct Unit { int pm, pn, kt0, nt, sub; };
struct Gemm { const bf16_t* A; const bf16_t* Bt; int M, N, K; };
struct StaticOrder {
    int nM, nN, nwg, G, c, rep, ntk;
    __host__ __device__ void init(int M_, int N_, int K_, int G_, int c_, int rep_ = 1) { nM = M_ / BM; nN = N_ / BM; nwg = nM * nN; G = G_; c = c_; rep = rep_; ntk = K_ / BK; }
    __host__ __device__ bool next(int i, Unit& u) const {
        if (rep > 1) { const int rounds = (nwg - c + G - 1) / G; if (i >= rounds * rep) return false; i = i % rounds; }
        const long L = (long)i * G + c; if (L >= nwg) return false;
        int wgid = (int)L; { const int q = nwg / NXCD, r = nwg % NXCD, xcd = wgid % NXCD, off = wgid / NXCD; wgid = (xcd < r ? xcd * (q + 1) : r * (q + 1) + (xcd - r) * q) + off; }
        const int nig = WGM * nN, gid = wgid / nig, fm = gid * WGM, gsz = (nM - fm) < WGM ? (nM - fm) : WGM;
        u.pm = fm + ((wgid % nig) % gsz); u.pn = (wgid % nig) / gsz; u.kt0 = 0; u.nt = ntk; u.sub = 0; return true;
    }
};
struct SplitOrder {
    StaticOrder base; int nfull, nsub, nslice, pm0, nNs;
    static constexpr int SUBK = 4;
    __host__ __device__ void init(int Mfull, int Mtot, int N_, int K_, int G_, int c_) { base.init(Mfull, N_, K_, G_, c_); nfull = (base.nwg - c_ + G_ - 1) / G_; if (nfull < 0) nfull = 0;
        nslice = (K_ / BK) / SUBK; nNs = N_ / BM; pm0 = Mfull / BM; nsub = ((Mtot - Mfull) / BM) * nNs * nslice; }
    __host__ __device__ bool next(int i, Unit& u) const {
        if (i < nfull) return base.next(i, u);
        const long s = (long)(i - nfull) * base.G + base.c; if (s >= nsub) return false;
        const int lu = (int)s / nslice, ks = (int)s % nslice;
        u.pm = pm0 + lu / nNs; u.pn = lu % nNs; u.kt0 = ks * SUBK; u.nt = SUBK; u.sub = 1; return true;
    }
};
template <class Epi, class Sched>
__device__ __forceinline__ void gemm_phase(LAS unsigned char* lds, const Gemm g, const Sched& S, const Epi& E) {
    const int tid = threadIdx.x, wid = __builtin_amdgcn_readfirstlane(tid >> 6), lane = tid & 63, wr = wid >> 2, wc = wid & 3, fr = lane & 15, fq = lane >> 4;
    const int K = g.K;
    unsigned voffA[2], voffB[2];
#pragma unroll
    for (int i = 0; i < 2; ++i) { int R, C; stage_rc(tid * 16 + i * 8192, R, C); const int Rb = Epi::PERM ? ((R & ~31) + perm32(R & 31)) : R;
        voffA[i] = (unsigned)(R * K + C) * 2u; voffB[i] = (unsigned)(Rb * K + C) * 2u; }
    const size_t kstep = (size_t)(BK * 2);
    const size_t hstep = (size_t)HALF * K * 2;
    const size_t tstep = 2 * hstep;
    const unsigned ldsw = (unsigned)wid * 1024u;
    const int aoff = lds_byte(wr * 64 + fr, fq * 8), boff = lds_byte(wc * 32 + fr, fq * 8);
#define PG8_SA(b, h) (((b) * 2 + (h)) * HTB)
#define PG8_SB(b, h) ((4 + (b) * 2 + (h)) * HTB)
#define PG8_STAGE(bufoff, gbase, voff) do { _Pragma("unroll") for (int _i = 0; _i < 2; ++_i) \
        __builtin_amdgcn_global_load_lds((const unsigned*)((const char*)(gbase) + (voff)[_i]), (LAS unsigned*)(lds + (bufoff) + ldsw + _i * 8192), 16, 0, 0); } while (0)
#define PG8_LDA(dst, b, h) do { _Pragma("unroll") for (int m = 0; m < 4; ++m) _Pragma("unroll") for (int k = 0; k < 2; ++k) dst[m][k] = *(const LAS bf16x8*)(lds + PG8_SA(b, h) + aoff + m * 2048 + k * 1024); } while (0)
#define PG8_LDB(dst, b, h) do { _Pragma("unroll") for (int n = 0; n < 2; ++n) _Pragma("unroll") for (int k = 0; k < 2; ++k) dst[n][k] = *(const LAS bf16x8*)(lds + PG8_SB(b, h) + boff + n * 2048 + k * 1024); } while (0)
#define PG8_MMA(ai, bj, At, Bt) do { __builtin_amdgcn_s_setprio(1); _Pragma("unroll") for (int m = 0; m < 4; ++m) _Pragma("unroll") for (int n = 0; n < 2; ++n) _Pragma("unroll") for (int k = 0; k < 2; ++k) \
        acc[ai][bj][m][n] = __builtin_amdgcn_mfma_f32_16x16x32_bf16(Bt[n][k], At[m][k], acc[ai][bj][m][n], 0, 0, 0); __builtin_amdgcn_s_setprio(0); } while (0)
#define PG8_WAIT_V(n) asm volatile("s_waitcnt vmcnt(" #n ")" ::: "memory")
#define PG8_WAIT_L(n) asm volatile("s_waitcnt lgkmcnt(" #n ")" ::: "memory")
#define PG8_BAR __builtin_amdgcn_s_barrier()
#define PG8_SCHED __builtin_amdgcn_sched_barrier(0)
    Unit cur, nxt; int ui = 0;
    if (!S.next(0, cur)) return;
    f32x4 acc[2][2][4][2];
#pragma unroll
    for (int a = 0; a < 2; ++a)
#pragma unroll
        for (int b = 0; b < 2; ++b)
#pragma unroll
            for (int m = 0; m < 4; ++m)
#pragma unroll
                for (int n = 0; n < 2; ++n) acc[a][b][m][n] = (f32x4){0.f, 0.f, 0.f, 0.f};
    bf16x8 At[4][2], B0[2][2], B1[2][2];
    const char* cA = (const char*)g.A + (size_t)cur.pm * tstep + (size_t)cur.kt0 * kstep; const char* cB = (const char*)g.Bt + (size_t)cur.pn * tstep + (size_t)cur.kt0 * kstep;
    PG8_STAGE(PG8_SB(0, 0), cB, voffB); PG8_STAGE(PG8_SA(0, 0), cA, voffA); PG8_STAGE(PG8_SB(0, 1), cB + hstep, voffB); PG8_STAGE(PG8_SA(0, 1), cA + hstep, voffA);
    if (wr == 1) PG8_BAR;
    PG8_WAIT_V(4); PG8_BAR;
    PG8_STAGE(PG8_SB(1, 0), cB + kstep, voffB); PG8_STAGE(PG8_SA(1, 0), cA + kstep, voffA); PG8_STAGE(PG8_SB(1, 1), cB + hstep + kstep, voffB);
    PG8_WAIT_V(6); PG8_BAR;
    for (;;) {
        const bool has_next = S.next(ui + 1, nxt);
        const char* nA = has_next ? (const char*)g.A + (size_t)nxt.pm * tstep + (size_t)nxt.kt0 * kstep : cA; const char* nB = has_next ? (const char*)g.Bt + (size_t)nxt.pn * tstep + (size_t)nxt.kt0 * kstep : cB;
        const int nt = cur.nt;
        for (int t = 0; t < nt; t += 2) {
            const bool last = (t == nt - 2);
            const char* a1 = cA + (size_t)(t + 1) * kstep;
            const char* a2 = last ? nA : cA + (size_t)(t + 2) * kstep; const char* b2 = last ? nB : cB + (size_t)(t + 2) * kstep;
            const char* a3 = a2 + kstep; const char* b3 = b2 + kstep;
            PG8_LDB(B0, 0, 0); PG8_SCHED; PG8_LDA(At, 0, 0); PG8_STAGE(PG8_SA(1, 1), a1 + hstep, voffA);
            PG8_WAIT_L(8); PG8_BAR; PG8_WAIT_L(0); PG8_MMA(0, 0, At, B0); PG8_BAR; PG8_SCHED;
            PG8_LDB(B1, 0, 1); PG8_STAGE(PG8_SB(0, 0), b2, voffB);
            PG8_BAR; PG8_WAIT_L(0); PG8_MMA(0, 1, At, B1); PG8_BAR;
            PG8_LDA(At, 0, 1); PG8_STAGE(PG8_SA(0, 0), a2, voffA);
            PG8_BAR; PG8_WAIT_L(0); PG8_MMA(1, 0, At, B0); PG8_BAR; PG8_SCHED;
            PG8_STAGE(PG8_SB(0, 1), b2 + hstep, voffB);
            PG8_WAIT_V(6); PG8_BAR; PG8_MMA(1, 1, At, B1); PG8_BAR;
            PG8_LDB(B0, 1, 0); PG8_SCHED; PG8_LDA(At, 1, 0); PG8_STAGE(PG8_SA(0, 1), a2 + hstep, voffA);
            PG8_WAIT_L(8); PG8_BAR; PG8_WAIT_L(0); PG8_MMA(0, 0, At, B0); PG8_BAR; PG8_SCHED;
            PG8_LDB(B1, 1, 1); PG8_STAGE(PG8_SB(1, 0), b3, voffB);
            PG8_BAR; PG8_WAIT_L(0); PG8_MMA(0, 1, At, B1); PG8_BAR;
            PG8_LDA(At, 1, 1); PG8_STAGE(PG8_SA(1, 0), a3, voffA);
            PG8_BAR; PG8_WAIT_L(0); PG8_MMA(1, 0, At, B0); PG8_BAR; PG8_SCHED;
            PG8_STAGE(PG8_SB(1, 1), b3 + hstep, voffB);
            PG8_WAIT_V(6); PG8_BAR; PG8_MMA(1, 1, At, B1); PG8_BAR;
        }
        E(acc, cur, wr, wc, fr, fq);
        if (!has_next) break;
#pragma unroll
        for (int a = 0; a < 2; ++a)
#pragma unroll
            for (int b = 0; b < 2; ++b)
#pragma unroll
                for (int m = 0; m < 4; ++m)
#pragma unroll
                    for (int n = 0; n < 2; ++n) acc[a][b][m][n] = (f32x4){0.f, 0.f, 0.f, 0.f};
        cur = nxt; cA = nA; cB = nB; ++ui;
    }
    PG8_WAIT_V(0);
    if (wr == 0) PG8_BAR;
    PG8_BAR;
#undef PG8_SA
#undef PG8_SB
#undef PG8_STAGE
#undef PG8_LDA
#undef PG8_LDB
#undef PG8_MMA
#undef PG8_WAIT_V
#undef PG8_WAIT_L
#undef PG8_BAR
#undef PG8_SCHED
}
}
using pg8::Unit; using pg8::HALF;

struct EpiIn {
    static constexpr bool PERM = true;
    bf16_t *CV, *BG, *UB;
    __device__ __forceinline__ void operator()(const f32x4 (&acc)[2][2][4][2], const Unit& u, int wr, int wc, int fr, int fq) const {
        const int row0 = u.pm * 256 + wr * 64 + fr;
        if (u.pn == 4 || u.pn == 5) {
            const int col0 = (u.pn - 4) * 256 + wc * 32 + 8 * fq;
#pragma unroll
            for (int ai = 0; ai < 2; ++ai)
#pragma unroll
                for (int m = 0; m < 4; ++m) { bf16_t* rowp = BG + (size_t)(row0 + ai * HALF + m * 16) * GW + col0;
#pragma unroll
                    for (int bj = 0; bj < 2; ++bj) { const f32x4 v0 = acc[ai][bj][m][0], v1 = acc[ai][bj][m][1];
                        u32x4 w; w.x = cvt_pk_bf16(v0[0], v0[1]); w.y = cvt_pk_bf16(v0[2], v0[3]); w.z = cvt_pk_bf16(v1[0], v1[1]); w.w = cvt_pk_bf16(v1[2], v1[3]);
                        *(u32x4*)(rowp + bj * HALF) = w; } }
        } else {
            const bool glu = u.pn >= 6; bf16_t* base = glu ? UB : CV; const int pq = glu ? u.pn - 6 : u.pn;
            const int col0 = pq * 128 + wc * 32 + 8 * fq;
#pragma unroll
            for (int ai = 0; ai < 2; ++ai)
#pragma unroll
                for (int m = 0; m < 4; ++m) { bf16_t* rowp = base + (size_t)(row0 + ai * HALF + m * 16) * GW + col0;
                    float o[8];
#pragma unroll
                    for (int n = 0; n < 2; ++n)
#pragma unroll
                        for (int j = 0; j < 4; ++j) { const float a = acc[ai][0][m][n][j], gt = acc[ai][1][m][n][j]; o[n * 4 + j] = glu ? a * sigmoidf_(gt) : a * gt; }
                    u32x4 w; w.x = cvt_pk_bf16(o[0], o[1]); w.y = cvt_pk_bf16(o[2], o[3]); w.z = cvt_pk_bf16(o[4], o[5]); w.w = cvt_pk_bf16(o[6], o[7]);
                    *(u32x4*)rowp = w; }
        }
    }
};
struct EpiOut {
    static constexpr bool PERM = true;
    const float *xp, *xs; bf16_t* X1B; float* SS;
    __device__ __forceinline__ void operator()(const f32x4 (&acc)[2][2][4][2], const Unit& u, int wr, int wc, int fr, int fq) const {
        const int row0 = u.pm * 256 + wr * 64 + fr, col0 = u.pn * 256 + wc * 32 + 8 * fq;
        const float* xb = (u.pm < NP / 256) ? xp : xs - (size_t)NP * D;
#pragma unroll
        for (int ai = 0; ai < 2; ++ai)
#pragma unroll
            for (int m = 0; m < 4; ++m) { const int row = row0 + ai * HALF + m * 16; const float* xr = xb + (size_t)row * D + col0; bf16_t* orow = X1B + (size_t)row * D + col0;
                float ss = 0.f;
#pragma unroll
                for (int bj = 0; bj < 2; ++bj) { const f32x4 x0 = *(const f32x4*)(xr + bj * HALF), x1 = *(const f32x4*)(xr + bj * HALF + 4);
                    const f32x4 v0 = acc[ai][bj][m][0] + x0, v1 = acc[ai][bj][m][1] + x1;
                    ss += (v0[0] * v0[0] + v0[1] * v0[1]) + (v0[2] * v0[2] + v0[3] * v0[3]) + (v1[0] * v1[0] + v1[1] * v1[1]) + (v1[2] * v1[2] + v1[3] * v1[3]);
                    u32x4 w; w.x = cvt_pk_bf16(v0[0], v0[1]); w.y = cvt_pk_bf16(v0[2], v0[3]); w.z = cvt_pk_bf16(v1[0], v1[1]); w.w = cvt_pk_bf16(v1[2], v1[3]);
                    *(u32x4*)(orow + bj * HALF) = w; }
                ss += __shfl_xor(ss, 16); ss += __shfl_xor(ss, 32);
                if (fq == 0) SS[(size_t)row * 16 + u.pn * 4 + wc] = ss;
                asm volatile("" ::: "memory"); }
    }
};
struct EpiGU {
    static constexpr bool PERM = true;
    const float* SS; bf16_t* F;
    __device__ __forceinline__ void operator()(const f32x4 (&acc)[2][2][4][2], const Unit& u, int wr, int wc, int fr, int fq) const {
        const int row0 = u.pm * 256 + wr * 64 + fr, col0 = u.pn * 128 + wc * 32 + 8 * fq;
#pragma unroll
        for (int ai = 0; ai < 2; ++ai)
#pragma unroll
            for (int m = 0; m < 4; ++m) { const int row = row0 + ai * HALF + m * 16; const f32x4* sp = (const f32x4*)(SS + (size_t)row * 16);
                const f32x4 s0 = sp[0], s1 = sp[1], s2 = sp[2], s3 = sp[3]; const f32x4 st = (s0 + s1) + (s2 + s3);
                const float r = __builtin_amdgcn_rsqf(((st[0] + st[1]) + (st[2] + st[3])) * (1.0f / D) + EPS);
                float o[8];
#pragma unroll
                for (int n = 0; n < 2; ++n)
#pragma unroll
                    for (int j = 0; j < 4; ++j) { const float gt = acc[ai][0][m][n][j] * r, up = acc[ai][1][m][n][j] * r; o[n * 4 + j] = gt * sigmoidf_(gt) * up; }
                u32x4 w; w.x = cvt_pk_bf16(o[0], o[1]); w.y = cvt_pk_bf16(o[2], o[3]); w.z = cvt_pk_bf16(o[4], o[5]); w.w = cvt_pk_bf16(o[6], o[7]);
                *(u32x4*)(F + (size_t)row * FF + col0) = w; }
    }
};
struct EpiDown {
    static constexpr bool PERM = true;
    const bf16_t* X1B; float* Y; float* SLAB;
    __device__ __forceinline__ void operator()(const f32x4 (&acc)[2][2][4][2], const Unit& u, int wr, int wc, int fr, int fq) const {
        const int row0 = u.pm * 256 + wr * 64 + fr, col0 = u.pn * 256 + wc * 32 + 8 * fq;
        if (u.sub) {
            float* sl = SLAB + (size_t)(u.kt0 / pg8::SplitOrder::SUBK) * NS * D - (size_t)NP * D;
#pragma unroll
            for (int ai = 0; ai < 2; ++ai)
#pragma unroll
                for (int m = 0; m < 4; ++m) { float* orow = sl + (size_t)(row0 + ai * HALF + m * 16) * D + col0;
#pragma unroll
                    for (int bj = 0; bj < 2; ++bj) { *(f32x4*)(orow + bj * HALF) = acc[ai][bj][m][0]; *(f32x4*)(orow + bj * HALF + 4) = acc[ai][bj][m][1]; } }
            return;
        }
#pragma unroll
        for (int ai = 0; ai < 2; ++ai)
#pragma unroll
            for (int m = 0; m < 4; ++m) { const int row = row0 + ai * HALF + m * 16; const bf16_t* xr = X1B + (size_t)row * D + col0; float* orow = Y + (size_t)row * D + col0;
#pragma unroll
                for (int bj = 0; bj < 2; ++bj) { const u32x4 xw = *(const u32x4*)(xr + bj * HALF);
                    const f32x4 x0 = {bf_lo(xw.x), bf_hi(xw.x), bf_lo(xw.y), bf_hi(xw.y)}, x1 = {bf_lo(xw.z), bf_hi(xw.z), bf_lo(xw.w), bf_hi(xw.w)};
                    *(f32x4*)(orow + bj * HALF) = acc[ai][bj][m][0] + x0; *(f32x4*)(orow + bj * HALF + 4) = acc[ai][bj][m][1] + x1; }
                asm volatile("" ::: "memory"); }
    }
};

struct Args {
    const float* in[17];
    float* out; unsigned char* ws;
};

__device__ __forceinline__ void p0_transpose_item(const float* W, int ldw, int col0, int k0, bf16_t* WT, int K, int drow0, const float* kscale, LAS float* scr, int lane) {
#pragma unroll 8
    for (int i = 0; i < 32; ++i) { const int kk = 2 * i + (lane >> 5); float v = W[(size_t)(k0 + kk) * ldw + col0 + (lane & 31)]; if (kscale) v *= kscale[k0 + kk]; scr[kk * 33 + (lane & 31)] = v; }
    asm volatile("s_waitcnt lgkmcnt(0)" ::: "memory");
    const int c = lane & 7;
#pragma unroll
    for (int j = 0; j < 4; ++j) { const int n = (lane >> 3) + 8 * j; const LAS float* s = scr + (8 * c) * 33 + n;
        u32x4 o; o.x = cvt_pk_bf16(s[0 * 33], s[1 * 33]); o.y = cvt_pk_bf16(s[2 * 33], s[3 * 33]); o.z = cvt_pk_bf16(s[4 * 33], s[5 * 33]); o.w = cvt_pk_bf16(s[6 * 33], s[7 * 33]);
        *(u32x4*)(WT + (size_t)(drow0 + n) * K + k0 + 8 * c) = o; }
    asm volatile("s_waitcnt lgkmcnt(0)" ::: "memory");
}
__device__ __forceinline__ const float* xrow_ptr(const float* xp, const float* xs, int m) { return m < NP ? xp + (size_t)m * D : xs + (size_t)(m - NP) * D; }

__device__ __forceinline__ void phase0(const Args& a, LAS unsigned char* lds, int wave, int lane) {
    LAS float* scr = (LAS float*)(lds + wave * 16384);
    const int gw = blockIdx.x * NWAVES + wave, NGW = gridDim.x * NWAVES;
    const float *w_in = a.in[5], *w_out = a.in[11], *g_ffn = a.in[12], *w_gate = a.in[13], *w_up = a.in[14], *w_down = a.in[15];
    bf16_t* WIN = (bf16_t*)(a.ws + WS_WIN); bf16_t* WOUT = (bf16_t*)(a.ws + WS_WOUT); bf16_t* WGU = (bf16_t*)(a.ws + WS_WGU); bf16_t* WDN = (bf16_t*)(a.ws + WS_WDN);
    constexpr int I_IN = (D / 64) * (INC / 32), I_OUT = (D / 64) * (D / 32), I_GU = (D / 64) * (GU / 32), I_DN = (FF / 64) * (D / 32);
    constexpr int NITEMS = I_IN + I_OUT + I_GU + I_DN;
    for (int it = gw; it < NITEMS; it += NGW) {
        int r = it;
        if (r < I_IN) { const int nblk = INC / 32, kb = r / nblk, R0 = (r % nblk) * 32;
            int col;
            if (R0 < 1024) { const int pn = R0 >> 8, w = R0 & 255; col = ((w < 128) ? 512 : 1024) + 128 * pn + (w & 127); }
            else if (R0 < 1536) col = R0 - 1024;
            else { const int q = R0 - 1536, pn = q >> 8, w = q & 255; col = ((w < 128) ? 1536 : 2048) + 128 * pn + (w & 127); }
            p0_transpose_item(w_in, INC, col, kb * 64, WIN, D, R0, nullptr, scr, lane); continue; }
        r -= I_IN;
        if (r < I_OUT) { const int nblk = D / 32, kb = r / nblk, R0 = (r % nblk) * 32; p0_transpose_item(w_out, D, R0, kb * 64, WOUT, D, R0, nullptr, scr, lane); continue; }
        r -= I_OUT;
        if (r < I_GU) { const int nblk = GU / 32, kb = r / nblk, R0 = (r % nblk) * 32; const int pn = R0 >> 8, w = R0 & 255;
            p0_transpose_item((w < 128) ? w_gate : w_up, FF, 128 * pn + (w & 127), kb * 64, WGU, D, R0, g_ffn, scr, lane); continue; }
        r -= I_GU;
        { const int nblk = D / 32, kb = r / nblk, R0 = (r % nblk) * 32; p0_transpose_item(w_down, D, R0, kb * 64, WDN, FF, R0, nullptr, scr, lane); }
    }
    const float* g_mix = a.in[4]; bf16_t* H = (bf16_t*)(a.ws + WS_H);
    f32x4 gm[4];
#pragma unroll
    for (int j = 0; j < 4; ++j) gm[j] = ((const f32x4*)g_mix)[lane + 64 * j];
    for (int m = gw; m < M; m += NGW) {
        const f32x4* xr = (const f32x4*)xrow_ptr(a.in[0], a.in[1], m) + lane;
        f32x4 v[4]; float s = 0.f;
#pragma unroll
        for (int j = 0; j < 4; ++j) { v[j] = xr[64 * j]; s += (v[j].x * v[j].x + v[j].y * v[j].y) + (v[j].z * v[j].z + v[j].w * v[j].w); }
        const float r = __builtin_amdgcn_rsqf(wave_sum(s) * (1.f / D) + EPS);
        u32x2* o8 = (u32x2*)(H + (size_t)m * D) + lane;
#pragma unroll
        for (int j = 0; j < 4; ++j) { u32x2 w; w.x = cvt_pk_bf16(v[j].x * r * gm[j].x, v[j].y * r * gm[j].y); w.y = cvt_pk_bf16(v[j].z * r * gm[j].z, v[j].w * r * gm[j].w); o8[64 * j] = w; }
    }
}

__device__ __forceinline__ void load8_bf16(const bf16_t* p, float (&v)[8]) {
    const u32x4 w = *(const u32x4*)p;
    v[0] = bf_lo(w.x); v[1] = bf_hi(w.x); v[2] = bf_lo(w.y); v[3] = bf_hi(w.y); v[4] = bf_lo(w.z); v[5] = bf_hi(w.z); v[6] = bf_lo(w.w); v[7] = bf_hi(w.w);
}
__device__ __forceinline__ void load8_f32(const float* p, float (&v)[8]) {
    const f32x4 a = *(const f32x4*)p, b = *(const f32x4*)(p + 4);
    v[0] = a.x; v[1] = a.y; v[2] = a.z; v[3] = a.w; v[4] = b.x; v[5] = b.y; v[6] = b.z; v[7] = b.w;
}
__device__ __forceinline__ void store8_f32(float* p, const float (&v)[8]) {
    *(f32x4*)p = (f32x4){v[0], v[1], v[2], v[3]}; *(f32x4*)(p + 4) = (f32x4){v[4], v[5], v[6], v[7]};
}
__device__ __forceinline__ void phase_conv(const Args& a, LAS unsigned char* lds, int wave, int lane) {
    const int tid = threadIdx.x;
    const float *state_a = a.in[2], *state_b = a.in[3], *conv_a_w = a.in[6], *conv_b_w = a.in[7], *conv_b_bias = a.in[8], *ln_g = a.in[9], *ln_b = a.in[10];
    const bf16_t* CV = (const bf16_t*)(a.ws + WS_CV); const bf16_t* BG = (const bf16_t*)(a.ws + WS_BG); const bf16_t* UB = (const bf16_t*)(a.ws + WS_UB);
    bf16_t* YM = (bf16_t*)(a.ws + WS_YM);
    LAS float* U = (LAS float*)lds; LAS float* CB = (LAS float*)(lds + CB_OFF);
    float wb[KB];
#pragma unroll
    for (int k = 0; k < KB; ++k) wb[k] = conv_b_w[k * GW + tid];
    const float bias = conv_b_bias[tid];
    const int c8 = (tid & 63) * 8, rsub = tid >> 6;
    for (int item = blockIdx.x; item < 640; item += gridDim.x) {
        int T, row0, pos0, L, seq; bool smp;
        if (item < 512) { seq = item >> 6; T = 32; pos0 = (item & 63) * 32; row0 = seq * SEQ + pos0; L = SEQ; smp = false; }
        else { seq = item - 512; T = 8; pos0 = 0; row0 = NP + seq * DSEQ; L = DSEQ; smp = true; }
        for (int s = rsub; s < T + 30; s += 8) { const int ts = pos0 - 30 + s; float v[8];
            if (ts >= 0) load8_bf16(UB + (size_t)(row0 - pos0 + ts) * GW + c8, v);
            else if (smp) load8_f32(state_b + ((size_t)seq * 30 + (30 + ts)) * GW + c8, v);
            else {
#pragma unroll
                for (int j = 0; j < 8; ++j) v[j] = 0.f; }
            *(LAS f32x4*)(U + s * GW + c8) = (f32x4){v[0], v[1], v[2], v[3]}; *(LAS f32x4*)(U + s * GW + c8 + 4) = (f32x4){v[4], v[5], v[6], v[7]}; }
        { float w0[8], w1[8], w2[8]; load8_f32(conv_a_w + c8, w0); load8_f32(conv_a_w + GW + c8, w1); load8_f32(conv_a_w + 2 * GW + c8, w2);
          for (int t = rsub; t < T; t += 8) { const int pos = pos0 + t, row = row0 + t; float c0[8], c1[8], c2[8], bg[8];
              load8_bf16(CV + (size_t)row * GW + c8, c0); load8_bf16(BG + (size_t)row * GW + c8, bg);
              if (pos >= 1) load8_bf16(CV + (size_t)(row - 1) * GW + c8, c1);
              else if (smp) load8_f32(state_a + ((size_t)seq * 2 + 1) * GW + c8, c1);
              else {
#pragma unroll
                  for (int j = 0; j < 8; ++j) c1[j] = 0.f; }
              if (pos >= 2) load8_bf16(CV + (size_t)(row - 2) * GW + c8, c2);
              else if (smp) load8_f32(state_a + ((size_t)seq * 2 + pos) * GW + c8, c2);
              else {
#pragma unroll
                  for (int j = 0; j < 8; ++j) c2[j] = 0.f; }
              float y[8];
#pragma unroll
              for (int j = 0; j < 8; ++j) y[j] = bg[j] * (w0[j] * c2[j] + w1[j] * c1[j] + w2[j] * c0[j]);
              u32x4 w; w.x = cvt_pk_bf16(y[0], y[1]); w.y = cvt_pk_bf16(y[2], y[3]); w.z = cvt_pk_bf16(y[4], y[5]); w.w = cvt_pk_bf16(y[6], y[7]);
              *(u32x4*)(YM + (size_t)row * D + c8) = w;
              if (pos >= L - 2) store8_f32(a.out + (smp ? O_NAS : O_NAP) + ((size_t)seq * 2 + (pos - (L - 2))) * GW + c8, c0);
          } }
        __syncthreads();
        for (int g = 0; g < T / 8; ++g) {
            float acc[8];
#pragma unroll
            for (int o = 0; o < 8; ++o) acc[o] = bias;
#pragma unroll
            for (int j = 0; j < 38; ++j) { const float v = U[(8 * g + j) * GW + tid];
#pragma unroll
                for (int o = 0; o < 8; ++o) { const int k = j - o; if (k >= 0 && k < KB) acc[o] += wb[k] * v; } }
#pragma unroll
            for (int o = 0; o < 8; ++o) CB[o * GW + tid] = acc[o];
            __syncthreads();
            { const f32x4 xa = *(const LAS f32x4*)(CB + wave * GW + lane * 8), xb = *(const LAS f32x4*)(CB + wave * GW + lane * 8 + 4);
              float x[8] = {xa.x, xa.y, xa.z, xa.w, xb.x, xb.y, xb.z, xb.w};
              float s = 0.f;
#pragma unroll
              for (int j = 0; j < 8; ++j) s += x[j];
              const float mean = wave_sum(s) * (1.f / GW); float q = 0.f;
#pragma unroll
              for (int j = 0; j < 8; ++j) { x[j] -= mean; q += x[j] * x[j]; }
              const float rstd = __builtin_amdgcn_rsqf(wave_sum(q) * (1.f / GW) + EPS);
              float gg[8], bb[8]; load8_f32(ln_g + lane * 8, gg); load8_f32(ln_b + lane * 8, bb);
              float y[8];
#pragma unroll
              for (int j = 0; j < 8; ++j) { const float z = x[j] * rstd * gg[j] + bb[j]; y[j] = z * sigmoidf_(z); }
              u32x4 w; w.x = cvt_pk_bf16(y[0], y[1]); w.y = cvt_pk_bf16(y[2], y[3]); w.z = cvt_pk_bf16(y[4], y[5]); w.w = cvt_pk_bf16(y[6], y[7]);
              *(u32x4*)(YM + (size_t)(row0 + 8 * g + wave) * D + GW + lane * 8) = w; }
            __syncthreads();
        }
        if (pos0 + T == L) {
            float* nb = a.out + (smp ? O_NBS : O_NBP) + (size_t)seq * 30 * GW;
            for (int i = rsub; i < 30; i += 8) { const f32x4 p = *(const LAS f32x4*)(U + (T + i) * GW + c8), q = *(const LAS f32x4*)(U + (T + i) * GW + c8 + 4);
                *(f32x4*)(nb + (size_t)i * GW + c8) = p; *(f32x4*)(nb + (size_t)i * GW + c8 + 4) = q; }
        }
        __syncthreads();
    }
}

__device__ __forceinline__ void phase_final(const Args& a, int wave, int lane) {
    const int gw = blockIdx.x * NWAVES + wave, NGW = gridDim.x * NWAVES;
    const float* g_final = a.in[16]; const float* SLAB = (const float*)(a.ws + WS_SLAB); const bf16_t* X1B = (const bf16_t*)(a.ws + WS_X1B);
    f32x4 gf[4];
#pragma unroll
    for (int j = 0; j < 4; ++j) gf[j] = ((const f32x4*)g_final)[lane + 64 * j];
    for (int ms = gw; ms < NS; ms += NGW) {
        const int m = NP + ms; f32x4 v[4];
        const u32x2* xr = (const u32x2*)(X1B + (size_t)m * D) + lane;
#pragma unroll
        for (int j = 0; j < 4; ++j) { const u32x2 w = xr[64 * j]; v[j] = (f32x4){bf_lo(w.x), bf_hi(w.x), bf_lo(w.y), bf_hi(w.y)}; }
#pragma unroll
        for (int ks = 0; ks < (FF / 64) / pg8::SplitOrder::SUBK; ++ks) { const f32x4* sr = (const f32x4*)(SLAB + ((size_t)ks * NS + ms) * D) + lane;
#pragma unroll
            for (int j = 0; j < 4; ++j) v[j] += sr[64 * j]; }
        float s = 0.f;
#pragma unroll
        for (int j = 0; j < 4; ++j) s += (v[j].x * v[j].x + v[j].y * v[j].y) + (v[j].z * v[j].z + v[j].w * v[j].w);
        const float r = __builtin_amdgcn_rsqf(wave_sum(s) * (1.f / D) + EPS);
        f32x4* yr = (f32x4*)(a.out + O_Y + (size_t)m * D) + lane;
#pragma unroll
        for (int j = 0; j < 4; ++j) yr[64 * j] = v[j] * r * gf[j];
    }
    for (int m = gw; m < NP; m += NGW) {
        f32x4* yr = (f32x4*)(a.out + O_Y + (size_t)m * D) + lane;
        f32x4 v[4]; float s = 0.f;
#pragma unroll
        for (int j = 0; j < 4; ++j) { v[j] = yr[64 * j]; s += (v[j].x * v[j].x + v[j].y * v[j].y) + (v[j].z * v[j].z + v[j].w * v[j].w); }
        const float r = __builtin_amdgcn_rsqf(wave_sum(s) * (1.f / D) + EPS);
#pragma unroll
        for (int j = 0; j < 4; ++j) yr[64 * j] = v[j] * r * gf[j];
    }
}

__global__ void __launch_bounds__(NTHREADS, 2) fwd_megakernel(Args a) {
    extern __shared__ __attribute__((aligned(16))) unsigned char lds_raw[];
    LAS unsigned char* lds = (LAS unsigned char*)lds_raw;
    const int tid = threadIdx.x, lane = tid & 63, wave = __builtin_amdgcn_readfirstlane(tid >> 6);
    volatile LAS unsigned* misc = (volatile LAS unsigned*)(lds + MISC_OFF);
    if (tid < 4) misc[tid] = 0u;
    __syncthreads();
    XcdBarrier bar = xcd_barrier_post((unsigned*)(a.ws + WS_CTL), misc);

    for (int rep = 0; rep < REP_P0; ++rep) phase0(a, lds, wave, lane);
    xcd_barrier(bar);
    {
        pg8::Gemm g{(const bf16_t*)(a.ws + WS_H), (const bf16_t*)(a.ws + WS_WIN), M, INC, D}; pg8::StaticOrder S; S.init(M, INC, D, gridDim.x, blockIdx.x, REP_GA);
        EpiIn E{(bf16_t*)(a.ws + WS_CV), (bf16_t*)(a.ws + WS_BG), (bf16_t*)(a.ws + WS_UB)};
        pg8::gemm_phase<EpiIn, pg8::StaticOrder>(lds, g, S, E);
    }
    xcd_barrier(bar);
    for (int rep = 0; rep < REP_PB; ++rep) phase_conv(a, lds, wave, lane);
    xcd_barrier(bar);
    {
        pg8::Gemm g{(const bf16_t*)(a.ws + WS_YM), (const bf16_t*)(a.ws + WS_WOUT), M, D, D}; pg8::StaticOrder S; S.init(M, D, D, gridDim.x, blockIdx.x, REP_GC);
        EpiOut E{a.in[0], a.in[1], (bf16_t*)(a.ws + WS_X1B), (float*)(a.ws + WS_SS1)};
        pg8::gemm_phase<EpiOut, pg8::StaticOrder>(lds, g, S, E);
    }
    xcd_barrier(bar);
    {
        pg8::Gemm g{(const bf16_t*)(a.ws + WS_X1B), (const bf16_t*)(a.ws + WS_WGU), M, GU, D}; pg8::StaticOrder S; S.init(M, GU, D, gridDim.x, blockIdx.x, REP_GD);
        EpiGU E{(const float*)(a.ws + WS_SS1), (bf16_t*)(a.ws + WS_F)};
        pg8::gemm_phase<EpiGU, pg8::StaticOrder>(lds, g, S, E);
    }
    xcd_barrier(bar);
    {
        pg8::Gemm g{(const bf16_t*)(a.ws + WS_F), (const bf16_t*)(a.ws + WS_WDN), M, D, FF}; pg8::SplitOrder S; S.init(NP, M, D, FF, gridDim.x, blockIdx.x);
        EpiDown E{(const bf16_t*)(a.ws + WS_X1B), a.out + O_Y, (float*)(a.ws + WS_SLAB)};
        pg8::gemm_phase<EpiDown, pg8::SplitOrder>(lds, g, S, E);
    }
    xcd_barrier(bar);
    phase_final(a, wave, lane);
}

extern "C" void kernel_launch(void* const* d_in, const int* in_sizes, int n_in, void* d_out, int out_size, void* d_ws, size_t ws_size, hipStream_t stream) {
    static int grid = 0;
    if (grid == 0) {
        if (n_in != 17 || ws_size < WS_END) { fprintf(stderr, "kernel_launch: unexpected n_in %d / ws %zu\n", n_in, ws_size); grid = -1; return; }
        int dev = 0, cus = 0, per_cu = 0;
        if (hipGetDevice(&dev) != hipSuccess || hipDeviceGetAttribute(&cus, hipDeviceAttributeMultiprocessorCount, dev) != hipSuccess) { grid = -1; return; }
        if (hipFuncSetAttribute((const void*)fwd_megakernel, hipFuncAttributeMaxDynamicSharedMemorySize, LDS_BYTES) != hipSuccess) { fprintf(stderr, "kernel_launch: hipFuncSetAttribute failed\n"); grid = -1; return; }
        if (hipOccupancyMaxActiveBlocksPerMultiprocessor(&per_cu, (const void*)fwd_megakernel, NTHREADS, LDS_BYTES) != hipSuccess || per_cu < 1) { fprintf(stderr, "kernel_launch: occupancy query says %d blocks per CU\n", per_cu); grid = -1; (void)hipGetLastError(); return; }
        grid = cus;
    }
    if (grid < 0) return;
    (void)hipMemsetAsync((char*)d_ws + WS_CTL, 0, CTL_BYTES, stream);
    Args a{};
    for (int i = 0; i < 17; ++i) a.in[i] = (const float*)d_in[i];
    a.out = (float*)d_out; a.ws = (unsigned char*)d_ws;
    hipLaunchKernelGGL(fwd_megakernel, dim3(grid), dim3(NTHREADS), LDS_BYTES, stream, a);
}
```

```cpp
#include <hip/hip_runtime.h>
#include <cstdio>

#define LAS __attribute__((address_space(3)))
#define REP_P0 1
#define REP_PB 1
#define REP_GA 1
#define REP_GC 1
#define REP_GD 1
#define REP_GE 1
#define PROBE_T 0
#define PROBE_T1 1
#define PROBE_T2 2
typedef unsigned short bf16_t;
typedef short bf16x8 __attribute__((ext_vector_type(8)));
typedef float f32x4 __attribute__((ext_vector_type(4)));
typedef float f32x2 __attribute__((ext_vector_type(2)));
typedef unsigned u32x4 __attribute__((ext_vector_type(4)));
typedef unsigned u32x2 __attribute__((ext_vector_type(2)));

constexpr int D = 1024, NP = 16384, NS = 1024, M = NP + NS;
constexpr int GW = 512, INC = 2560, FF = 2816, GU = 2 * FF;
constexpr int SEQ = 2048, NB = 8, DSEQ = 8, DB = 128, KA = 3, KB = 31;
constexpr float EPS = 1e-6f;
constexpr size_t O_Y = 0, O_NAP = (size_t)M * D, O_NBP = O_NAP + (size_t)NB * 2 * GW, O_NAS = O_NBP + (size_t)NB * 30 * GW, O_NBS = O_NAS + (size_t)DB * 2 * GW;
constexpr size_t WS_CTL = 0, CTL_BYTES = 65536, CTL_CNT = 16384, CTL_SC = 49152;
constexpr size_t WS_WIN = WS_CTL + CTL_BYTES;
constexpr size_t WS_WOUT = WS_WIN + (size_t)INC * D * 2;
constexpr size_t WS_WGU = WS_WOUT + (size_t)D * D * 2;
constexpr size_t WS_WDN = WS_WGU + (size_t)GU * D * 2;
constexpr size_t WS_SS1 = WS_WDN + (size_t)D * FF * 2;
constexpr size_t WS_X1B = WS_SS1 + (size_t)M * 16 * 4;
constexpr size_t WS_R1 = WS_X1B + (size_t)M * D * 2;
constexpr size_t WS_H = WS_R1;
constexpr size_t WS_CV = WS_H + (size_t)M * D * 2;
constexpr size_t WS_BG = WS_CV + (size_t)M * GW * 2;
constexpr size_t WS_UB = WS_BG + (size_t)M * GW * 2;
constexpr size_t WS_YM = WS_UB + (size_t)M * GW * 2;
constexpr size_t WS_F = WS_R1;
constexpr size_t WS_SLAB = WS_YM + (size_t)M * D * 2;
constexpr size_t WS_XS = WS_SLAB + (size_t)11 * NS * D * 4;
constexpr size_t WS_R = WS_XS + (size_t)NP * 16 * 4;
constexpr size_t WS_R0 = WS_R + (size_t)M * 4;
constexpr size_t WS_END = WS_R0 + (size_t)M * 4;
static_assert((size_t)M * FF * 2 <= WS_SLAB - WS_R1, "F overlay");
static_assert((FF / 64) % 4 == 0 && (FF / 64) / 4 == 11 && (D / 64) / 4 == 4, "slab count");
static_assert(WS_END <= (size_t)256 * 1024 * 1024, "workspace");

constexpr int NTHREADS = 512, NWAVES = 8;
constexpr int LDS_BYTES = 144 * 1024, MISC_OFF = LDS_BYTES - 16;
constexpr int SPARE_OFF = 128 * 1024;
constexpr int U_ROWS = 62, CB_OFF = U_ROWS * GW * 4;
static_assert(CB_OFF + 8 * GW * 4 <= MISC_OFF, "lds");

__device__ __forceinline__ unsigned cvt_pk_bf16(float lo, float hi) { unsigned r; asm volatile("v_cvt_pk_bf16_f32 %0, %1, %2" : "=v"(r) : "v"(lo), "v"(hi)); return r; }
__device__ __forceinline__ float bf_lo(unsigned w) { return __uint_as_float(w << 16); }
__device__ __forceinline__ float bf_hi(unsigned w) { return __uint_as_float(w & 0xffff0000u); }
__device__ __forceinline__ float sigmoidf_(float x) { return __builtin_amdgcn_rcpf(1.0f + __expf(-x)); }
__device__ __forceinline__ void st16_wt(void* p, u32x4 v) { asm volatile("global_store_dwordx4 %0, %1, off sc1\n\ts_nop 1" :: "v"(p), "v"(v) : "memory"); }
__device__ __forceinline__ float wave_sum(float v) {
#pragma unroll
    for (int o = 1; o < 64; o <<= 1) v += __shfl_xor(v, o);
    return v;
}

#define XB_TMO      128
#define XB_XCNT(j)  (256  + 64 * (j))
#define XB_XSUB(j)  (1280 + 64 * (j))
#define XB_XGEN(j)  (2304 + 64 * (j))
#define XB_TOP      3328
#define XB_TOPGEN   3392
#define XCD_BAR_WORDS 3456
#define XB_SPIN_CAP (1u << 18)
static_assert(XCD_BAR_WORDS * 4 <= CTL_CNT && CTL_CNT + 128 * 256 <= CTL_BYTES, "ctl");
__device__ __forceinline__ unsigned xb_ld(unsigned* p)              { return __hip_atomic_load(p, __ATOMIC_RELAXED, __HIP_MEMORY_SCOPE_AGENT); }
__device__ __forceinline__ unsigned xb_add(unsigned* p, unsigned v) { return __hip_atomic_fetch_add(p, v, __ATOMIC_RELAXED, __HIP_MEMORY_SCOPE_AGENT); }
__device__ __forceinline__ unsigned xb_xcc_id() { return (unsigned)__builtin_amdgcn_s_getreg((3 << 11) | 20) & 0xFu; }
#define XB_SPIN(cond, bar) do { unsigned _sp = 0; while (cond) { __builtin_amdgcn_s_sleep(1); \
    if ((++_sp & 255u) == 0u) { if (xb_ld(&(bar)[XB_TMO])) break; if (_sp > XB_SPIN_CAP) { atomicAdd(&(bar)[XB_TMO], 1u); break; } } } } while (0)
struct XcdBarrier { unsigned* bar; unsigned x; volatile LAS unsigned* st; };
__device__ __forceinline__ XcdBarrier xcd_barrier_post(unsigned* bar, volatile LAS unsigned* st) {
    XcdBarrier b; b.bar = bar; b.x = xb_xcc_id(); b.st = st;
    if (threadIdx.x == 0) (void)xb_add(&bar[XB_XCNT(b.x)], 1u);
    return b;
}
__device__ __forceinline__ void xcd_barrier_complete(unsigned* bar, unsigned x, unsigned& nloc, unsigned& nx) {
    const unsigned G = gridDim.x * gridDim.y * gridDim.z;
    unsigned sum, cnt, mine, sp = 0u;
    for (;;) {
        sum = 0u; cnt = 0u; mine = 0u;
#pragma unroll
        for (unsigned j = 0; j < 16; ++j) { const unsigned c = xb_ld(&bar[XB_XCNT(j)]); sum += c; cnt += (c > 0u) ? 1u : 0u; mine = (j == x) ? c : mine; }
        if (sum == G) break;
        __builtin_amdgcn_s_sleep(1);
        if ((++sp & 255u) == 0u) { if (xb_ld(&bar[XB_TMO])) break; if (sp > XB_SPIN_CAP) { atomicAdd(&bar[XB_TMO], 1u); break; } }
    }
    nloc = mine > 0u ? mine : 1u; nx = cnt > 0u ? cnt : 1u;
}
template <bool ACQ = true>
__device__ __forceinline__ void xcd_barrier(const XcdBarrier& b) {
    asm volatile("s_waitcnt vmcnt(0)" ::: "memory");
    __syncthreads();
    if (threadIdx.x == 0) {
        unsigned* bar = b.bar;
        __builtin_amdgcn_s_waitcnt(0);
        unsigned nloc = b.st[0], nx = b.st[1];
        if (nloc == 0u) { xcd_barrier_complete(bar, b.x, nloc, nx); b.st[0] = nloc; b.st[1] = nx; }
        const unsigned bg = b.st[2];
        const unsigned old = xb_add(&bar[XB_XSUB(b.x)], 1u);
        const unsigned gen = old / nloc;
        bool released = false;
        if (old + 1u == (gen + 1u) * nloc) {
            __builtin_amdgcn_fence(__ATOMIC_RELEASE, "agent");
            asm volatile("s_waitcnt vmcnt(0)" ::: "memory");
            const unsigned og = xb_add(&bar[XB_TOP], 1u);
            const unsigned tg = og / nx;
            if (og + 1u == (tg + 1u) * nx) { xb_add(&bar[XB_TOPGEN], 1u); released = true; }
        }
        if (ACQ) asm volatile("buffer_inv sc1" ::: "memory");
        if (!released) XB_SPIN(xb_ld(&bar[XB_TOPGEN]) == bg, bar);
        b.st[2] = bg + 1u;
        if (ACQ) asm volatile("s_waitcnt vmcnt(0)" ::: "memory");
    }
    asm volatile("" ::: "memory");
    __syncthreads();
}

namespace pg8 {
constexpr int BM = 256, BK = 64, HALF = 128, HTB = HALF * BK * 2, STAGE_BYTES = 8 * HTB, NXCD = 8, WGM = 8;
__host__ __device__ __forceinline__ int lds_byte(int r, int c) { const int st = (r >> 4) * 2 + (c >> 5), rr = r & 15, cc = c & 31, ob = rr * 64 + cc * 2; return st * 1024 + (ob ^ (((ob >> 9) & 1) << 5)); }
__host__ __device__ __forceinline__ void stage_rc(int b, int& R, int& C) { const int st = b / 1024, sb = b % 1024, swz = sb ^ (((sb >> 9) & 1) << 5); R = (st >> 1) * 16 + swz / 64; C = (st & 1) * 32 + (swz % 64) / 2; }
__host__ __device__ __forceinline__ int perm32(int rho) { const int n = rho >> 4, i = rho & 15; return 8 * (i >> 2) + 4 * n + (i & 3); }
struct Unit { int pm, pn, kt0, nt, sub; };
struct Gemm { const bf16_t* A; const bf16_t* Bt; int M, N, K; };
struct StaticOrder {
    int nM, nN, nwg, G, c, rep, ntk; bool rev = false;
    __host__ __device__ void init(int M_, int N_, int K_, int G_, int c_, int rep_ = 1) { nM = M_ / BM; nN = N_ / BM; nwg = nM * nN; G = G_; c = c_; rep = rep_; ntk = K_ / BK; }
    __host__ __device__ bool next(int i, Unit& u) const {
        if (rep > 1) { const int rounds = (nwg - c + G - 1) / G; if (i >= rounds * rep) return false; i = i % rounds; }
        const long L = (long)i * G + c; if (L >= nwg) return false;
        int wgid = (int)L; { const int q = nwg / NXCD, r = nwg % NXCD, xcd = wgid % NXCD, off = wgid / NXCD; wgid = (xcd < r ? xcd * (q + 1) : r * (q + 1) + (xcd - r) * q) + off; }
        if (rev) wgid = nwg - 1 - wgid;
        const int nig = WGM * nN, gid = wgid / nig, fm = gid * WGM, gsz = (nM - fm) < WGM ? (nM - fm) : WGM;
        u.pm = fm + ((wgid % nig) % gsz); u.pn = (wgid % nig) / gsz; u.kt0 = 0; u.nt = ntk; u.sub = 0; return true;
    }
};
struct SplitOrder {
    StaticOrder base; int nfull, nsub, nslice, pm0, nNs;
    static constexpr int SUBK = 4;
    __host__ __device__ void init(int Mfull, int Mtot, int N_, int K_, int G_, int c_) { base.init(Mfull, N_, K_, G_, c_); nfull = (base.nwg - c_ + G_ - 1) / G_; if (nfull < 0) nfull = 0;
        nslice = (K_ / BK) / SUBK; nNs = N_ / BM; pm0 = Mfull / BM; nsub = ((Mtot - Mfull) / BM) * nNs * nslice; }
    __host__ __device__ bool next(int i, Unit& u) const {
        if (i < nfull) return base.next(i, u);
        const long s = (long)(i - nfull) * base.G + base.c; if (s >= nsub) return false;
        const int lu = (int)s / nslice, ks = (int)s % nslice;
        u.pm = pm0 + lu / nNs; u.pn = lu % nNs; u.kt0 = ks * SUBK; u.nt = SUBK; u.sub = 1; return true;
    }
};
template <class Epi, class Sched>
__device__ __forceinline__ void gemm_phase(LAS unsigned char* lds, const Gemm g, const Sched& S, const Epi& E) {
    const int tid = threadIdx.x, wid = __builtin_amdgcn_readfirstlane(tid >> 6), lane = tid & 63, wr = wid >> 2, wc = wid & 3, fr = lane & 15, fq = lane >> 4;
    const int K = g.K;
    unsigned voffA[2], voffB[2];
#pragma unroll
    for (int i = 0; i < 2; ++i) { int R, C; stage_rc(tid * 16 + i * 8192, R, C); const int Rb = Epi::PERM ? ((R & ~31) + perm32(R & 31)) : R;
        voffA[i] = (unsigned)(R * K + C) * 2u; voffB[i] = (unsigned)(Rb * K + C) * 2u; }
    const size_t kstep = (size_t)(BK * 2);
    const size_t hstep = (size_t)HALF * K * 2;
    const size_t tstep = 2 * hstep;
    const unsigned ldsw = (unsigned)wid * 1024u;
    const int aoff = lds_byte(wr * 64 + fr, fq * 8), boff = lds_byte(wc * 32 + fr, fq * 8);
#define PG8_SA(b, h) (((b) * 2 + (h)) * HTB)
#define PG8_SB(b, h) ((4 + (b) * 2 + (h)) * HTB)
#define PG8_STAGE(bufoff, gbase, voff) do { _Pragma("unroll") for (int _i = 0; _i < 2; ++_i) \
        __builtin_amdgcn_global_load_lds((const unsigned*)((const char*)(gbase) + (voff)[_i]), (LAS unsigned*)(lds + (bufoff) + ldsw + _i * 8192), 16, 0, 0); } while (0)
#define PG8_LDA(dst, b, h) do { _Pragma("unroll") for (int m = 0; m < 4; ++m) _Pragma("unroll") for (int k = 0; k < 2; ++k) dst[m][k] = *(const LAS bf16x8*)(lds + PG8_SA(b, h) + aoff + m * 2048 + k * 1024); } while (0)
#define PG8_LDB(dst, b, h) do { _Pragma("unroll") for (int n = 0; n < 2; ++n) _Pragma("unroll") for (int k = 0; k < 2; ++k) dst[n][k] = *(const LAS bf16x8*)(lds + PG8_SB(b, h) + boff + n * 2048 + k * 1024); } while (0)
#define PG8_MMA(ai, bj, At, Bt) do { __builtin_amdgcn_s_setprio(1); _Pragma("unroll") for (int m = 0; m < 4; ++m) _Pragma("unroll") for (int n = 0; n < 2; ++n) _Pragma("unroll") for (int k = 0; k < 2; ++k) \
        acc[ai][bj][m][n] = __builtin_amdgcn_mfma_f32_16x16x32_bf16(Bt[n][k], At[m][k], acc[ai][bj][m][n], 0, 0, 0); __builtin_amdgcn_s_setprio(0); } while (0)
#define PG8_WAIT_V(n) asm volatile("s_waitcnt vmcnt(" #n ")" ::: "memory")
#define PG8_WAIT_L(n) asm volatile("s_waitcnt lgkmcnt(" #n ")" ::: "memory")
#define PG8_BAR __builtin_amdgcn_s_barrier()
#define PG8_SCHED __builtin_amdgcn_sched_barrier(0)
    Unit cur, nxt; int ui = 0;
    if (!S.next(0, cur)) return;
    f32x4 acc[2][2][4][2];
#pragma unroll
    for (int a = 0; a < 2; ++a)
#pragma unroll
        for (int b = 0; b < 2; ++b)
#pragma unroll
            for (int m = 0; m < 4; ++m)
#pragma unroll
                for (int n = 0; n < 2; ++n) acc[a][b][m][n] = (f32x4){0.f, 0.f, 0.f, 0.f};
    bf16x8 At[4][2], B0[2][2], B1[2][2];
    const char* cA = (const char*)g.A + (size_t)cur.pm * tstep + (size_t)cur.kt0 * kstep; const char* cB = (const char*)g.Bt + (size_t)cur.pn * tstep + (size_t)cur.kt0 * kstep;
    PG8_STAGE(PG8_SB(0, 0), cB, voffB); PG8_STAGE(PG8_SA(0, 0), cA, voffA); PG8_STAGE(PG8_SB(0, 1), cB + hstep, voffB); PG8_STAGE(PG8_SA(0, 1), cA + hstep, voffA);
    if (wr == 1) PG8_BAR;
    PG8_WAIT_V(4); PG8_BAR;
    PG8_STAGE(PG8_SB(1, 0), cB + kstep, voffB); PG8_STAGE(PG8_SA(1, 0), cA + kstep, voffA); PG8_STAGE(PG8_SB(1, 1), cB + hstep + kstep, voffB);
    PG8_WAIT_V(6); PG8_BAR;
    for (;;) {
        const bool has_next = S.next(ui + 1, nxt);
        const char* nA = has_next ? (const char*)g.A + (size_t)nxt.pm * tstep + (size_t)nxt.kt0 * kstep : cA; const char* nB = has_next ? (const char*)g.Bt + (size_t)nxt.pn * tstep + (size_t)nxt.kt0 * kstep : cB;
        const int nt = cur.nt;
        for (int t = 0; t < nt; t += 2) {
            const bool last = (t == nt - 2);
            const char* a1 = cA + (size_t)(t + 1) * kstep;
            const char* a2 = last ? nA : cA + (size_t)(t + 2) * kstep; const char* b2 = last ? nB : cB + (size_t)(t + 2) * kstep;
            const char* a3 = a2 + kstep; const char* b3 = b2 + kstep;
            if (last) E.pre(lds, cur, wid, wr, lane);
            PG8_LDB(B0, 0, 0); PG8_SCHED; PG8_LDA(At, 0, 0); PG8_STAGE(PG8_SA(1, 1), a1 + hstep, voffA);
            PG8_WAIT_L(8); PG8_BAR; PG8_WAIT_L(0); PG8_MMA(0, 0, At, B0); PG8_BAR; PG8_SCHED;
            PG8_LDB(B1, 0, 1); PG8_STAGE(PG8_SB(0, 0), b2, voffB);
            PG8_BAR; PG8_WAIT_L(0); PG8_MMA(0, 1, At, B1); PG8_BAR;
            PG8_LDA(At, 0, 1); PG8_STAGE(PG8_SA(0, 0), a2, voffA);
            PG8_BAR; PG8_WAIT_L(0); PG8_MMA(1, 0, At, B0); PG8_BAR; PG8_SCHED;
            PG8_STAGE(PG8_SB(0, 1), b2 + hstep, voffB);
            PG8_WAIT_V(6); PG8_BAR; PG8_MMA(1, 1, At, B1); PG8_BAR;
            PG8_LDB(B0, 1, 0); PG8_SCHED; PG8_LDA(At, 1, 0); PG8_STAGE(PG8_SA(0, 1), a2 + hstep, voffA);
            PG8_WAIT_L(8); PG8_BAR; PG8_WAIT_L(0); PG8_MMA(0, 0, At, B0); PG8_BAR; PG8_SCHED;
            PG8_LDB(B1, 1, 1); PG8_STAGE(PG8_SB(1, 0), b3, voffB);
            PG8_BAR; PG8_WAIT_L(0); PG8_MMA(0, 1, At, B1); PG8_BAR;
            PG8_LDA(At, 1, 1); PG8_STAGE(PG8_SA(1, 0), a3, voffA);
            PG8_BAR; PG8_WAIT_L(0); PG8_MMA(1, 0, At, B0); PG8_BAR; PG8_SCHED;
            PG8_STAGE(PG8_SB(1, 1), b3 + hstep, voffB);
            PG8_WAIT_V(6); PG8_BAR; PG8_MMA(1, 1, At, B1); PG8_BAR;
        }
        if (wr == 0) PG8_BAR;
        E(acc, cur, wr, wc, fr, fq, lds);
        if (!has_next) break;
        if (wr == 1) PG8_BAR;
#pragma unroll
        for (int a = 0; a < 2; ++a)
#pragma unroll
            for (int b = 0; b < 2; ++b)
#pragma unroll
                for (int m = 0; m < 4; ++m)
#pragma unroll
                    for (int n = 0; n < 2; ++n) acc[a][b][m][n] = (f32x4){0.f, 0.f, 0.f, 0.f};
        cur = nxt; cA = nA; cB = nB; ++ui;
    }
    PG8_WAIT_V(0);
    PG8_BAR;
#undef PG8_SA
#undef PG8_SB
#undef PG8_STAGE
#undef PG8_LDA
#undef PG8_LDB
#undef PG8_MMA
#undef PG8_WAIT_V
#undef PG8_WAIT_L
#undef PG8_BAR
#undef PG8_SCHED
}
}
using pg8::Unit; using pg8::HALF;

struct EpiIn {
    static constexpr bool PERM = true;
    bf16_t *CV, *BG, *UB; const float* R0; unsigned* sc; bool handoff;
    __device__ __forceinline__ void pre(LAS unsigned char* lds, const Unit& u, int wid, int wr, int lane) const {
        const float* rp = R0 + u.pm * 256 + wr * 64 + lane;
#pragma unroll
        for (int ai = 0; ai < 2; ++ai) __builtin_amdgcn_global_load_lds((const unsigned*)(rp + ai * HALF), (LAS unsigned*)(lds + SPARE_OFF + wid * 512 + ai * 256), 4, 0, 0);
    }
    __device__ __forceinline__ void operator()(const f32x4 (&acc)[2][2][4][2], const Unit& u, int wr, int wc, int fr, int fq, LAS unsigned char* lds) const {
        const int row0 = u.pm * 256 + wr * 64 + fr; const bool wt = handoff && u.pm >= NP / 256;
        const LAS float* rl_ = (const LAS float*)(lds + SPARE_OFF + (wr * 4 + wc) * 512);
        if (u.pn == 4 || u.pn == 5) {
            const int col0 = (u.pn - 4) * 256 + wc * 32 + 8 * fq;
#pragma unroll
            for (int ai = 0; ai < 2; ++ai)
#pragma unroll
                for (int m = 0; m < 4; ++m) { bf16_t* rowp = BG + (size_t)(row0 + ai * HALF + m * 16) * GW + col0; const float r = rl_[ai * 64 + m * 16 + fr];
#pragma unroll
                    for (int bj = 0; bj < 2; ++bj) { const f32x4 v0 = acc[ai][bj][m][0] * r, v1 = acc[ai][bj][m][1] * r;
                        u32x4 w; w.x = cvt_pk_bf16(v0[0], v0[1]); w.y = cvt_pk_bf16(v0[2], v0[3]); w.z = cvt_pk_bf16(v1[0], v1[1]); w.w = cvt_pk_bf16(v1[2], v1[3]);
                        if (wt) st16_wt(rowp + bj * HALF, w); else *(u32x4*)(rowp + bj * HALF) = w; } }
        } else {
            const bool glu = u.pn >= 6; bf16_t* base = glu ? UB : CV; const int pq = glu ? u.pn - 6 : u.pn;
            const int col0 = pq * 128 + wc * 32 + 8 * fq;
#pragma unroll
            for (int ai = 0; ai < 2; ++ai)
#pragma unroll
                for (int m = 0; m < 4; ++m) { bf16_t* rowp = base + (size_t)(row0 + ai * HALF + m * 16) * GW + col0; const float r = rl_[ai * 64 + m * 16 + fr], r2 = r * r;
                    float o[8];
#pragma unroll
                    for (int n = 0; n < 2; ++n)
#pragma unroll
                        for (int j = 0; j < 4; ++j) { const float av = acc[ai][0][m][n][j], gt = acc[ai][1][m][n][j]; o[n * 4 + j] = glu ? (av * r) * sigmoidf_(gt * r) : (av * gt) * r2; }
                    u32x4 w; w.x = cvt_pk_bf16(o[0], o[1]); w.y = cvt_pk_bf16(o[2], o[3]); w.z = cvt_pk_bf16(o[4], o[5]); w.w = cvt_pk_bf16(o[6], o[7]);
                    if (wt) st16_wt(rowp, w); else *(u32x4*)rowp = w; }
        }
        if (wt) { asm volatile("s_waitcnt vmcnt(0)" ::: "memory");
            if ((threadIdx.x & 63) == 0) __hip_atomic_fetch_add(sc, 1u, __ATOMIC_RELAXED, __HIP_MEMORY_SCOPE_AGENT); }
    }
};
struct EpiOut {
    static constexpr bool PERM = true;
    const bf16_t* XB; bf16_t* X1B; float* SS; bf16_t* SLAB;
    __device__ __forceinline__ void pre(LAS unsigned char*, const Unit&, int, int, int) const {}
    __device__ __forceinline__ void operator()(const f32x4 (&acc)[2][2][4][2], const Unit& u, int wr, int wc, int fr, int fq, LAS unsigned char* lds) const {
        const int row0 = u.pm * 256 + wr * 64 + fr, col0 = u.pn * 256 + wc * 32 + 8 * fq;
        if (u.sub) {
            bf16_t* sl = SLAB + (size_t)(u.kt0 / pg8::SplitOrder::SUBK) * NS * D - (size_t)NP * D;
#pragma unroll
            for (int ai = 0; ai < 2; ++ai)
#pragma unroll
                for (int m = 0; m < 4; ++m) { bf16_t* orow = sl + (size_t)(row0 + ai * HALF + m * 16) * D + col0;
#pragma unroll
                    for (int bj = 0; bj < 2; ++bj) { const f32x4 v0 = acc[ai][bj][m][0], v1 = acc[ai][bj][m][1];
                        u32x4 w; w.x = cvt_pk_bf16(v0[0], v0[1]); w.y = cvt_pk_bf16(v0[2], v0[3]); w.z = cvt_pk_bf16(v1[0], v1[1]); w.w = cvt_pk_bf16(v1[2], v1[3]);
                        *(u32x4*)(orow + bj * HALF) = w; } }
            return;
        }
#pragma unroll
        for (int ai = 0; ai < 2; ++ai) {
            u32x4 xw[4][2];
#pragma unroll
            for (int m = 0; m < 4; ++m) { const bf16_t* xr = XB + (size_t)(row0 + ai * HALF + m * 16) * D + col0; xw[m][0] = *(const u32x4*)xr; xw[m][1] = *(const u32x4*)(xr + HALF); }
#pragma unroll
            for (int m = 0; m < 4; ++m) { const int row = row0 + ai * HALF + m * 16; bf16_t* orow = X1B + (size_t)row * D + col0;
                float ss = 0.f;
#pragma unroll
                for (int bj = 0; bj < 2; ++bj) { const u32x4 q = xw[m][bj];
                    const f32x4 x0 = {bf_lo(q.x), bf_hi(q.x), bf_lo(q.y), bf_hi(q.y)}, x1 = {bf_lo(q.z), bf_hi(q.z), bf_lo(q.w), bf_hi(q.w)};
                    const f32x4 v0 = acc[ai][bj][m][0] + x0, v1 = acc[ai][bj][m][1] + x1;
                    ss += (v0[0] * v0[0] + v0[1] * v0[1]) + (v0[2] * v0[2] + v0[3] * v0[3]) + (v1[0] * v1[0] + v1[1] * v1[1]) + (v1[2] * v1[2] + v1[3] * v1[3]);
                    u32x4 w; w.x = cvt_pk_bf16(v0[0], v0[1]); w.y = cvt_pk_bf16(v0[2], v0[3]); w.z = cvt_pk_bf16(v1[0], v1[1]); w.w = cvt_pk_bf16(v1[2], v1[3]);
                    *(u32x4*)(orow + bj * HALF) = w; }
                ss += __shfl_xor(ss, 16); ss += __shfl_xor(ss, 32);
                if (fq == 0) SS[(size_t)row * 16 + u.pn * 4 + wc] = ss; }
            asm volatile("" ::: "memory"); }
    }
};
struct EpiGU {
    static constexpr bool PERM = true;
    const float* R; bf16_t* F;
    __device__ __forceinline__ void pre(LAS unsigned char* lds, const Unit& u, int wid, int wr, int lane) const {
        const float* rp = R + u.pm * 256 + wr * 64 + lane;
#pragma unroll
        for (int ai = 0; ai < 2; ++ai) __builtin_amdgcn_global_load_lds((const unsigned*)(rp + ai * HALF), (LAS unsigned*)(lds + SPARE_OFF + wid * 512 + ai * 256), 4, 0, 0);
    }
    __device__ __forceinline__ void operator()(const f32x4 (&acc)[2][2][4][2], const Unit& u, int wr, int wc, int fr, int fq, LAS unsigned char* lds) const {
        const LAS float* rl_ = (const LAS float*)(lds + SPARE_OFF + (wr * 4 + wc) * 512);
        const int row0 = u.pm * 256 + wr * 64 + fr, col0 = u.pn * 128 + wc * 32 + 8 * fq;
#pragma unroll
        for (int ai = 0; ai < 2; ++ai)
#pragma unroll
            for (int m = 0; m < 4; ++m) { const int row = row0 + ai * HALF + m * 16; const float r = rl_[ai * 64 + m * 16 + fr]; const f32x2 r2 = {r, r}, rl = {r * -1.4426950409f, r * -1.4426950409f};
                f32x2 o[4];
#pragma unroll
                for (int n = 0; n < 2; ++n)
#pragma unroll
                    for (int jp = 0; jp < 2; ++jp) { const f32x2 ga = {acc[ai][0][m][n][2 * jp], acc[ai][0][m][n][2 * jp + 1]}, ua = {acc[ai][1][m][n][2 * jp], acc[ai][1][m][n][2 * jp + 1]};
                        const f32x2 t = ga * rl; f32x2 e; e.x = __builtin_amdgcn_exp2f(t.x); e.y = __builtin_amdgcn_exp2f(t.y);
                        const f32x2 d = e + 1.0f; f32x2 sg; sg.x = __builtin_amdgcn_rcpf(d.x); sg.y = __builtin_amdgcn_rcpf(d.y);
                        o[n * 2 + jp] = ((ga * r2) * sg) * (ua * r2); }
                u32x4 w; w.x = cvt_pk_bf16(o[0].x, o[0].y); w.y = cvt_pk_bf16(o[1].x, o[1].y); w.z = cvt_pk_bf16(o[2].x, o[2].y); w.w = cvt_pk_bf16(o[3].x, o[3].y);
                *(u32x4*)(F + (size_t)row * FF + col0) = w; }
    }
};
struct EpiDown {
    static constexpr bool PERM = true;
    const bf16_t* X1B; float* Y; bf16_t* SLAB; float* XS; unsigned* cnt; const float* gfin;
    __device__ __forceinline__ void pre(LAS unsigned char*, const Unit&, int, int, int) const {}
    __device__ __forceinline__ void operator()(f32x4 (&acc)[2][2][4][2], const Unit& u, int wr, int wc, int fr, int fq, LAS unsigned char* lds) const {
        const int row0 = u.pm * 256 + wr * 64 + fr, col0 = u.pn * 256 + wc * 32 + 8 * fq;
        if (u.sub) {
            bf16_t* sl = SLAB + (size_t)(u.kt0 / pg8::SplitOrder::SUBK) * NS * D - (size_t)NP * D;
#pragma unroll
            for (int ai = 0; ai < 2; ++ai)
#pragma unroll
                for (int m = 0; m < 4; ++m) { bf16_t* orow = sl + (size_t)(row0 + ai * HALF + m * 16) * D + col0;
#pragma unroll
                    for (int bj = 0; bj < 2; ++bj) { const f32x4 v0 = acc[ai][bj][m][0], v1 = acc[ai][bj][m][1];
                        u32x4 w; w.x = cvt_pk_bf16(v0[0], v0[1]); w.y = cvt_pk_bf16(v0[2], v0[3]); w.z = cvt_pk_bf16(v1[0], v1[1]); w.w = cvt_pk_bf16(v1[2], v1[3]);
                        *(u32x4*)(orow + bj * HALF) = w; } }
            return;
        }
#pragma unroll
        for (int ai = 0; ai < 2; ++ai) {
            u32x4 xw[4][2];
#pragma unroll
            for (int m = 0; m < 4; ++m) { const bf16_t* xr = X1B + (size_t)(row0 + ai * HALF + m * 16) * D + col0; xw[m][0] = *(const u32x4*)xr; xw[m][1] = *(const u32x4*)(xr + HALF); }
#pragma unroll
            for (int m = 0; m < 4; ++m) { const int row = row0 + ai * HALF + m * 16;
                float ss = 0.f;
#pragma unroll
                for (int bj = 0; bj < 2; ++bj) { const u32x4 q = xw[m][bj];
                    const f32x4 x0 = {bf_lo(q.x), bf_hi(q.x), bf_lo(q.y), bf_hi(q.y)}, x1 = {bf_lo(q.z), bf_hi(q.z), bf_lo(q.w), bf_hi(q.w)};
                    const f32x4 v0 = acc[ai][bj][m][0] + x0, v1 = acc[ai][bj][m][1] + x1; acc[ai][bj][m][0] = v0; acc[ai][bj][m][1] = v1;
                    ss += (v0[0] * v0[0] + v0[1] * v0[1]) + (v0[2] * v0[2] + v0[3] * v0[3]) + (v1[0] * v1[0] + v1[1] * v1[1]) + (v1[2] * v1[2] + v1[3] * v1[3]); }
                ss += __shfl_xor(ss, 16); ss += __shfl_xor(ss, 32);
                if (fq == 0) __hip_atomic_store(XS + (size_t)row * 16 + u.pn * 4 + wc, ss, __ATOMIC_RELAXED, __HIP_MEMORY_SCOPE_AGENT);
            }
            asm volatile("" ::: "memory"); }
        asm volatile("s_waitcnt vmcnt(0)" ::: "memory");
        unsigned* cw = cnt + 64 * (u.pm * 2 + wr);
        if ((threadIdx.x & 63) == 0) __hip_atomic_fetch_add(cw, 1u, __ATOMIC_RELAXED, __HIP_MEMORY_SCOPE_AGENT);
        { unsigned sp = 0;
          while ((unsigned)__builtin_amdgcn_readfirstlane(__hip_atomic_load(cw, __ATOMIC_RELAXED, __HIP_MEMORY_SCOPE_AGENT)) < 16u) { __builtin_amdgcn_s_sleep(2); if (++sp > (1u << 16)) break; } }
        asm volatile("" ::: "memory");
        f32x4 g0[2], g1[2];
#pragma unroll
        for (int bj = 0; bj < 2; ++bj) { g0[bj] = *(const f32x4*)(gfin + col0 + bj * HALF); g1[bj] = *(const f32x4*)(gfin + col0 + bj * HALF + 4); }
        float tq[2][4];
#pragma unroll
        for (int ai = 0; ai < 2; ++ai)
#pragma unroll
            for (int m = 0; m < 4; ++m) { const float* xs = XS + (size_t)(row0 + ai * HALF + m * 16) * 16 + fq * 4;
                tq[ai][m] = (__hip_atomic_load(xs, __ATOMIC_RELAXED, __HIP_MEMORY_SCOPE_AGENT) + __hip_atomic_load(xs + 1, __ATOMIC_RELAXED, __HIP_MEMORY_SCOPE_AGENT))
                          + (__hip_atomic_load(xs + 2, __ATOMIC_RELAXED, __HIP_MEMORY_SCOPE_AGENT) + __hip_atomic_load(xs + 3, __ATOMIC_RELAXED, __HIP_MEMORY_SCOPE_AGENT)); }
#pragma unroll
        for (int ai = 0; ai < 2; ++ai)
#pragma unroll
            for (int m = 0; m < 4; ++m) { const int row = row0 + ai * HALF + m * 16;
                float t = tq[ai][m]; t += __shfl_xor(t, 16); t += __shfl_xor(t, 32);
                const float r = __builtin_amdgcn_rsqf(t * (1.0f / D) + EPS);
                float* orow = Y + (size_t)row * D + col0;
#pragma unroll
                for (int bj = 0; bj < 2; ++bj) { *(f32x4*)(orow + bj * HALF) = acc[ai][bj][m][0] * r * g0[bj]; *(f32x4*)(orow + bj * HALF + 4) = acc[ai][bj][m][1] * r * g1[bj]; } }
    }
};

struct Args {
    const float* in[17];
    float* out; unsigned char* ws;
};

__device__ __forceinline__ void p0_transpose_item(const float* W, int ldw, int col0, int k0, bf16_t* WT, int K, int drow0, const float* kscale, LAS float* scr, int lane) {
    float tv[32];
#pragma unroll
    for (int i = 0; i < 32; ++i) { const int kk = 2 * i + (lane >> 5); tv[i] = __builtin_nontemporal_load(W + (size_t)(k0 + kk) * ldw + col0 + (lane & 31)); }
    if (kscale) {
#pragma unroll
        for (int i = 0; i < 32; ++i) tv[i] *= kscale[k0 + 2 * i + (lane >> 5)]; }
#pragma unroll
    for (int i = 0; i < 32; ++i) scr[(2 * i + (lane >> 5)) * 33 + (lane & 31)] = tv[i];
    asm volatile("s_waitcnt lgkmcnt(0)" ::: "memory");
    const int c = lane & 7;
#pragma unroll
    for (int j = 0; j < 4; ++j) { const int n = (lane >> 3) + 8 * j; const LAS float* s = scr + (8 * c) * 33 + n;
        u32x4 o; o.x = cvt_pk_bf16(s[0 * 33], s[1 * 33]); o.y = cvt_pk_bf16(s[2 * 33], s[3 * 33]); o.z = cvt_pk_bf16(s[4 * 33], s[5 * 33]); o.w = cvt_pk_bf16(s[6 * 33], s[7 * 33]);
        *(u32x4*)(WT + (size_t)(drow0 + n) * K + k0 + 8 * c) = o; }
    asm volatile("s_waitcnt lgkmcnt(0)" ::: "memory");
}
__device__ __forceinline__ const float* xrow_ptr(const float* xp, const float* xs, int m) { return m < NP ? xp + (size_t)m * D : xs + (size_t)(m - NP) * D; }

template <int WHICH>
__device__ __forceinline__ void convert_weights(const Args& a, LAS unsigned char* lds, int wave, int lane, int gw, int NGW) {
    LAS float* scr = (LAS float*)(lds + wave * 16384);
    const float *w_in = a.in[5], *w_out = a.in[11], *g_ffn = a.in[12], *w_gate = a.in[13], *w_up = a.in[14], *w_down = a.in[15];
    bf16_t* WIN = (bf16_t*)(a.ws + WS_WIN); bf16_t* WOUT = (bf16_t*)(a.ws + WS_WOUT); bf16_t* WGU = (bf16_t*)(a.ws + WS_WGU); bf16_t* WDN = (bf16_t*)(a.ws + WS_WDN);
    constexpr int I_IN = (D / 64) * (INC / 32), I_OUT = (D / 64) * (D / 32), I_GU = (D / 64) * (GU / 32), I_DN = (FF / 64) * (D / 32);
    constexpr int NITEMS = WHICH == 0 ? I_IN + I_OUT : (WHICH == 1 ? I_GU : I_DN);
    for (int it = gw; it < NITEMS; it += NGW) {
        int r = it;
        if (WHICH == 0) {
            if (r < I_IN) { const int nblk = INC / 32, kb = r / nblk, R0 = (r % nblk) * 32;
                int col;
                if (R0 < 1024) { const int pn = R0 >> 8, w = R0 & 255; col = ((w < 128) ? 512 : 1024) + 128 * pn + (w & 127); }
                else if (R0 < 1536) col = R0 - 1024;
                else { const int q = R0 - 1536, pn = q >> 8, w = q & 255; col = ((w < 128) ? 1536 : 2048) + 128 * pn + (w & 127); }
                p0_transpose_item(w_in, INC, col, kb * 64, WIN, D, R0, a.in[4], scr, lane); continue; }
            r -= I_IN;
            { const int nblk = D / 32, kb = r / nblk, R0 = (r % nblk) * 32; p0_transpose_item(w_out, D, R0, kb * 64, WOUT, D, R0, nullptr, scr, lane); }
        } else if (WHICH == 1) {
            const int nblk = GU / 32, kb = r / nblk, R0 = (r % nblk) * 32; const int pn = R0 >> 8, w = R0 & 255;
            p0_transpose_item((w < 128) ? w_gate : w_up, FF, 128 * pn + (w & 127), kb * 64, WGU, D, R0, g_ffn, scr, lane);
        } else {
            const int nblk = D / 32, kb = r / nblk, R0 = (r % nblk) * 32; p0_transpose_item(w_down, D, R0, kb * 64, WDN, FF, R0, nullptr, scr, lane);
        }
    }
}
__device__ __forceinline__ void phase0(const Args& a, LAS unsigned char* lds, int wave, int lane) {
    const int gw = blockIdx.x * NWAVES + wave, NGW = gridDim.x * NWAVES;
    convert_weights<0>(a, lds, wave, lane, gw, NGW);
    bf16_t* H = (bf16_t*)(a.ws + WS_H); float* R0 = (float*)(a.ws + WS_R0);
    for (int m0 = gw; m0 < M; m0 += 4 * NGW) {
        f32x4 v[4][4]; float ss[4];
#pragma unroll
        for (int q = 0; q < 4; ++q) { const int m = (m0 + q * NGW < M) ? m0 + q * NGW : m0; const f32x4* xr = (const f32x4*)xrow_ptr(a.in[0], a.in[1], m) + lane;
#pragma unroll
            for (int j = 0; j < 4; ++j) v[q][j] = __builtin_nontemporal_load(xr + 64 * j); }
#pragma unroll
        for (int q = 0; q < 4; ++q) { float s = 0.f; const int m = m0 + q * NGW;
#pragma unroll
            for (int j = 0; j < 4; ++j) s += (v[q][j].x * v[q][j].x + v[q][j].y * v[q][j].y) + (v[q][j].z * v[q][j].z + v[q][j].w * v[q][j].w);
            ss[q] = s;
            if (m < M) { u32x2* o8 = (u32x2*)(H + (size_t)m * D) + lane;
#pragma unroll
                for (int j = 0; j < 4; ++j) { u32x2 w; w.x = cvt_pk_bf16(v[q][j].x, v[q][j].y); w.y = cvt_pk_bf16(v[q][j].z, v[q][j].w); o8[64 * j] = w; } } }
#pragma unroll
        for (int o = 1; o < 64; o <<= 1) {
#pragma unroll
            for (int q = 0; q < 4; ++q) ss[q] += __shfl_xor(ss[q], o); }
#pragma unroll
        for (int q = 0; q < 4; ++q) { const int m = m0 + q * NGW; if (m < M && lane == 0) R0[m] = __builtin_amdgcn_rsqf(ss[q] * (1.f / D) + EPS); }
    }
}

__device__ __forceinline__ void load8_bf16(const bf16_t* p, float (&v)[8]) {
    const u32x4 w = *(const u32x4*)p;
    v[0] = bf_lo(w.x); v[1] = bf_hi(w.x); v[2] = bf_lo(w.y); v[3] = bf_hi(w.y); v[4] = bf_lo(w.z); v[5] = bf_hi(w.z); v[6] = bf_lo(w.w); v[7] = bf_hi(w.w);
}
__device__ __forceinline__ void load8_f32(const float* p, float (&v)[8]) {
    const f32x4 a = *(const f32x4*)p, b = *(const f32x4*)(p + 4);
    v[0] = a.x; v[1] = a.y; v[2] = a.z; v[3] = a.w; v[4] = b.x; v[5] = b.y; v[6] = b.z; v[7] = b.w;
}
__device__ __forceinline__ void store8_f32(float* p, const float (&v)[8]) {
    *(f32x4*)p = (f32x4){v[0], v[1], v[2], v[3]}; *(f32x4*)(p + 4) = (f32x4){v[4], v[5], v[6], v[7]};
}
__device__ __forceinline__ void phase_conv(const Args& a, LAS unsigned char* lds, int wave, int lane, int item0, int item_end, int item_step) {
    const int tid = wave * 64 + lane;
    const float *state_a = a.in[2], *state_b = a.in[3], *conv_a_w = a.in[6], *conv_b_w = a.in[7], *conv_b_bias = a.in[8], *ln_g = a.in[9], *ln_b = a.in[10];
    const bf16_t* CV = (const bf16_t*)(a.ws + WS_CV); const bf16_t* BG = (const bf16_t*)(a.ws + WS_BG); const bf16_t* UB = (const bf16_t*)(a.ws + WS_UB);
    bf16_t* YM = (bf16_t*)(a.ws + WS_YM);
    LAS float* U = (LAS float*)lds; LAS float* CB = (LAS float*)(lds + CB_OFF);
    float wb[KB];
#pragma unroll
    for (int k = 0; k < KB; ++k) wb[k] = conv_b_w[k * GW + tid];
    const float bias = conv_b_bias[tid];
    const int c8 = (tid & 63) * 8, rsub = tid >> 6;
    for (int item = item0; item < item_end; item += item_step) {
        int T, row0, pos0, L, seq; bool smp;
        if (item < 512) { seq = item >> 6; T = 32; pos0 = (item & 63) * 32; row0 = seq * SEQ + pos0; L = SEQ; smp = false; }
        else { seq = item - 512; T = 8; pos0 = 0; row0 = NP + seq * DSEQ; L = DSEQ; smp = true; }
        float w0[8], w1[8], w2[8]; load8_f32(conv_a_w + c8, w0); load8_f32(conv_a_w + GW + c8, w1); load8_f32(conv_a_w + 2 * GW + c8, w2);
        if (!smp) {
            u32x4 raw[8], c0r[4], bgr[4], c1r[4], c2r[4]; const u32x4 zz = {0u, 0u, 0u, 0u};
#pragma unroll
            for (int p = 0; p < 8; ++p) { const int s = rsub + 8 * p, ts = pos0 - 30 + s; raw[p] = (s < 62 && ts >= 0) ? *(const u32x4*)(UB + (size_t)(row0 - 30 + s) * GW + c8) : zz; }
#pragma unroll
            for (int p = 0; p < 4; ++p) { const int t = rsub + 8 * p, pos = pos0 + t, row = row0 + t;
                c0r[p] = *(const u32x4*)(CV + (size_t)row * GW + c8); bgr[p] = *(const u32x4*)(BG + (size_t)row * GW + c8);
                c1r[p] = (pos >= 1) ? *(const u32x4*)(CV + (size_t)(row - 1) * GW + c8) : zz; c2r[p] = (pos >= 2) ? *(const u32x4*)(CV + (size_t)(row - 2) * GW + c8) : zz; }
#pragma unroll
            for (int p = 0; p < 8; ++p) { const int s = rsub + 8 * p; const u32x4 w = raw[p];
                if (s < 62) { *(LAS f32x4*)(U + s * GW + c8) = (f32x4){bf_lo(w.x), bf_hi(w.x), bf_lo(w.y), bf_hi(w.y)}; *(LAS f32x4*)(U + s * GW + c8 + 4) = (f32x4){bf_lo(w.z), bf_hi(w.z), bf_lo(w.w), bf_hi(w.w)}; } }
#pragma unroll
            for (int p = 0; p < 4; ++p) { const int t = rsub + 8 * p, pos = pos0 + t, row = row0 + t;
                const u32x4 a0 = c0r[p], a1 = c1r[p], a2 = c2r[p], bw = bgr[p];
                const float c0[8] = {bf_lo(a0.x), bf_hi(a0.x), bf_lo(a0.y), bf_hi(a0.y), bf_lo(a0.z), bf_hi(a0.z), bf_lo(a0.w), bf_hi(a0.w)};
                const float c1[8] = {bf_lo(a1.x), bf_hi(a1.x), bf_lo(a1.y), bf_hi(a1.y), bf_lo(a1.z), bf_hi(a1.z), bf_lo(a1.w), bf_hi(a1.w)};
                const float c2[8] = {bf_lo(a2.x), bf_hi(a2.x), bf_lo(a2.y), bf_hi(a2.y), bf_lo(a2.z), bf_hi(a2.z), bf_lo(a2.w), bf_hi(a2.w)};
                const float bg[8] = {bf_lo(bw.x), bf_hi(bw.x), bf_lo(bw.y), bf_hi(bw.y), bf_lo(bw.z), bf_hi(bw.z), bf_lo(bw.w), bf_hi(bw.w)};
                float y[8];
#pragma unroll
                for (int j = 0; j < 8; ++j) y[j] = bg[j] * (w0[j] * c2[j] + w1[j] * c1[j] + w2[j] * c0[j]);
                u32x4 w; w.x = cvt_pk_bf16(y[0], y[1]); w.y = cvt_pk_bf16(y[2], y[3]); w.z = cvt_pk_bf16(y[4], y[5]); w.w = cvt_pk_bf16(y[6], y[7]);
                *(u32x4*)(YM + (size_t)row * D + c8) = w;
                if (pos >= L - 2) store8_f32(a.out + O_NAP + ((size_t)seq * 2 + (pos - (L - 2))) * GW + c8, c0); }
        } else {
        for (int s = rsub; s < T + 30; s += 8) { const int ts = pos0 - 30 + s; float v[8];
            if (ts >= 0) load8_bf16(UB + (size_t)(row0 - pos0 + ts) * GW + c8, v);
            else load8_f32(state_b + ((size_t)seq * 30 + (30 + ts)) * GW + c8, v);
            *(LAS f32x4*)(U + s * GW + c8) = (f32x4){v[0], v[1], v[2], v[3]}; *(LAS f32x4*)(U + s * GW + c8 + 4) = (f32x4){v[4], v[5], v[6], v[7]}; }
        { const int t = rsub; const int pos = pos0 + t, row = row0 + t; float c0[8], c1[8], c2[8], bg[8];
              load8_bf16(CV + (size_t)row * GW + c8, c0); load8_bf16(BG + (size_t)row * GW + c8, bg);
              if (pos >= 1) load8_bf16(CV + (size_t)(row - 1) * GW + c8, c1); else load8_f32(state_a + ((size_t)seq * 2 + 1) * GW + c8, c1);
              if (pos >= 2) load8_bf16(CV + (size_t)(row - 2) * GW + c8, c2); else load8_f32(state_a + ((size_t)seq * 2 + pos) * GW + c8, c2);
              float y[8];
#pragma unroll
              for (int j = 0; j < 8; ++j) y[j] = bg[j] * (w0[j] * c2[j] + w1[j] * c1[j] + w2[j] * c0[j]);
              u32x4 w; w.x = cvt_pk_bf16(y[0], y[1]); w.y = cvt_pk_bf16(y[2], y[3]); w.z = cvt_pk_bf16(y[4], y[5]); w.w = cvt_pk_bf16(y[6], y[7]);
              *(u32x4*)(YM + (size_t)row * D + c8) = w;
              if (pos >= L - 2) store8_f32(a.out + O_NAS + ((size_t)seq * 2 + (pos - (L - 2))) * GW + c8, c0); }
        }
        __syncthreads();
        for (int g = 0; g < T / 8; ++g) {
            float acc[8];
#pragma unroll
            for (int o = 0; o < 8; ++o) acc[o] = bias;
#pragma unroll
            for (int j = 0; j < 38; ++j) { const float v = U[(8 * g + j) * GW + tid];
#pragma unroll
                for (int o = 0; o < 8; ++o) { const int k = j - o; if (k >= 0 && k < KB) acc[o] += wb[k] * v; } }
#pragma unroll
            for (int o = 0; o < 8; ++o) CB[o * GW + tid] = acc[o];
            __syncthreads();
            { const f32x4 xa = *(const LAS f32x4*)(CB + wave * GW + lane * 8), xb = *(const LAS f32x4*)(CB + wave * GW + lane * 8 + 4);
              float x[8] = {xa.x, xa.y, xa.z, xa.w, xb.x, xb.y, xb.z, xb.w};
              float s = 0.f;
#pragma unroll
              for (int j = 0; j < 8; ++j) s += x[j];
              const float mean = wave_sum(s) * (1.f / GW); float q = 0.f;
#pragma unroll
              for (int j = 0; j < 8; ++j) { x[j] -= mean; q += x[j] * x[j]; }
              const float rstd = __builtin_amdgcn_rsqf(wave_sum(q) * (1.f / GW) + EPS);
              float gg[8], bb[8]; load8_f32(ln_g + lane * 8, gg); load8_f32(ln_b + lane * 8, bb);
              float y[8];
#pragma unroll
              for (int j = 0; j < 8; ++j) { const float z = x[j] * rstd * gg[j] + bb[j]; y[j] = z * sigmoidf_(z); }
              u32x4 w; w.x = cvt_pk_bf16(y[0], y[1]); w.y = cvt_pk_bf16(y[2], y[3]); w.z = cvt_pk_bf16(y[4], y[5]); w.w = cvt_pk_bf16(y[6], y[7]);
              *(u32x4*)(YM + (size_t)(row0 + 8 * g + wave) * D + GW + lane * 8) = w; }
            __syncthreads();
        }
        if (pos0 + T == L) {
            float* nb = a.out + (smp ? O_NBS : O_NBP) + (size_t)seq * 30 * GW;
            for (int i = rsub; i < 30; i += 8) { const f32x4 p = *(const LAS f32x4*)(U + (T + i) * GW + c8), q = *(const LAS f32x4*)(U + (T + i) * GW + c8 + 4);
                *(f32x4*)(nb + (size_t)i * GW + c8) = p; *(f32x4*)(nb + (size_t)i * GW + c8 + 4) = q; }
        }
        __syncthreads();
    }
}

__device__ __forceinline__ void phase_fixup(const Args& a, int wave, int lane) {
    const int gw = blockIdx.x * NWAVES + wave, NGW = gridDim.x * NWAVES;
    const bf16_t* SLAB = (const bf16_t*)(a.ws + WS_SLAB); bf16_t* X1B = (bf16_t*)(a.ws + WS_X1B); const float* SS1 = (const float*)(a.ws + WS_SS1); float* R1 = (float*)(a.ws + WS_R);
    for (int ms = gw; ms < NS; ms += NGW) {
        const int m = NP + ms; f32x4 v[4], p[4][4];
        const f32x4* xr = (const f32x4*)(a.in[1] + (size_t)ms * D) + lane;
#pragma unroll
        for (int j = 0; j < 4; ++j) v[j] = xr[64 * j];
#pragma unroll
        for (int ks = 0; ks < 4; ++ks) { const u32x2* sr = (const u32x2*)(SLAB + ((size_t)ks * NS + ms) * D) + lane;
#pragma unroll
            for (int j = 0; j < 4; ++j) { const u32x2 w = sr[64 * j]; p[ks][j] = (f32x4){bf_lo(w.x), bf_hi(w.x), bf_lo(w.y), bf_hi(w.y)}; } }
        float s = 0.f;
#pragma unroll
        for (int j = 0; j < 4; ++j) { v[j] += (p[0][j] + p[1][j]) + (p[2][j] + p[3][j]); s += (v[j].x * v[j].x + v[j].y * v[j].y) + (v[j].z * v[j].z + v[j].w * v[j].w); }
        s = wave_sum(s);
        u32x2* o8 = (u32x2*)(X1B + (size_t)m * D) + lane;
#pragma unroll
        for (int j = 0; j < 4; ++j) { u32x2 w; w.x = cvt_pk_bf16(v[j].x, v[j].y); w.y = cvt_pk_bf16(v[j].z, v[j].w); o8[64 * j] = w; }
        if (lane == 0) R1[m] = __builtin_amdgcn_rsqf(s * (1.f / D) + EPS);
    }
    const bool spare = NGW >= 2 * NS;
    if (spare && gw < NS) return;
    for (int m = spare ? (gw - NS) * 64 + lane : (int)(blockIdx.x * NTHREADS + threadIdx.x); m < NP; m += spare ? (NGW - NS) * 64 : (int)(gridDim.x * NTHREADS)) { const f32x4* sp = (const f32x4*)(SS1 + (size_t)m * 16);
        const f32x4 st = (sp[0] + sp[1]) + (sp[2] + sp[3]); R1[m] = __builtin_amdgcn_rsqf(((st[0] + st[1]) + (st[2] + st[3])) * (1.0f / D) + EPS); }
}

__device__ __forceinline__ void unpack_add(const u32x4 w, float (&v)[8], bool init) {
    const float t[8] = {bf_lo(w.x), bf_hi(w.x), bf_lo(w.y), bf_hi(w.y), bf_lo(w.z), bf_hi(w.z), bf_lo(w.w), bf_hi(w.w)};
#pragma unroll
    for (int j = 0; j < 8; ++j) v[j] = init ? t[j] : v[j] + t[j];
}
__device__ __forceinline__ void phase_final(const Args& a, LAS unsigned char* lds, int wave, int lane) {
    const float* g_final = a.in[16]; const bf16_t* SLAB = (const bf16_t*)(a.ws + WS_SLAB); const bf16_t* X1B = (const bf16_t*)(a.ws + WS_X1B);
    LAS float* red = (LAS float*)lds;
    const int rw = wave >> 1, hf = wave & 1, c0 = hf * 512 + lane * 8;
    float gf[8]; load8_f32(g_final + c0, gf);
    for (int ms0 = blockIdx.x * 4; ms0 < NS; ms0 += gridDim.x * 4) {
        const int ms = ms0 + rw, m = NP + ms;
        u32x4 raw[12];
        raw[0] = *(const u32x4*)(X1B + (size_t)m * D + c0);
#pragma unroll
        for (int ks = 0; ks < 11; ++ks) raw[1 + ks] = *(const u32x4*)(SLAB + ((size_t)ks * NS + ms) * D + c0);
        float v[8]; unpack_add(raw[0], v, true);
#pragma unroll
        for (int ks = 0; ks < 11; ++ks) unpack_add(raw[1 + ks], v, false);
        float s = 0.f;
#pragma unroll
        for (int j = 0; j < 8; ++j) s += v[j] * v[j];
        s = wave_sum(s);
        if (lane == 0) red[wave] = s;
        __syncthreads();
        const float r = __builtin_amdgcn_rsqf((red[rw * 2] + red[rw * 2 + 1]) * (1.f / D) + EPS);
        float* yr = a.out + O_Y + (size_t)m * D + c0;
        *(f32x4*)yr = (f32x4){v[0] * r * gf[0], v[1] * r * gf[1], v[2] * r * gf[2], v[3] * r * gf[3]};
        *(f32x4*)(yr + 4) = (f32x4){v[4] * r * gf[4], v[5] * r * gf[5], v[6] * r * gf[6], v[7] * r * gf[7]};
        __syncthreads();
    }
}

__device__ __forceinline__ int fresh_tid() { int t = threadIdx.x; asm volatile("" : "+v"(t)); return t; }
#define PHASE_IDS const int t_ = fresh_tid(); const int wave = __builtin_amdgcn_readfirstlane(t_ >> 6), lane = t_ & 63
__global__ void __launch_bounds__(NTHREADS, 2) fwd_megakernel(Args a) {
    extern __shared__ __attribute__((aligned(16))) unsigned char lds_raw[];
    LAS unsigned char* lds = (LAS unsigned char*)lds_raw;
    const int tid = threadIdx.x;
    volatile LAS unsigned* misc = (volatile LAS unsigned*)(lds + MISC_OFF);
    if (tid < 4) misc[tid] = 0u;
    __syncthreads();
    XcdBarrier bar = xcd_barrier_post((unsigned*)(a.ws + WS_CTL), misc);
    unsigned long long ts0 = 0, ts1 = 0, ts2 = 0, ts3 = 0, ts4 = 0, ts5 = 0, ts6 = 0, ts7 = 0;
#define STAMP(v) do { if (PROBE_T) v = __builtin_amdgcn_s_memrealtime(); } while (0)
    STAMP(ts0);

    { PHASE_IDS; phase0(a, lds, wave, lane); }
    xcd_barrier<false>(bar);
    STAMP(ts1);
    bool tailconv = false;
    {
        pg8::Gemm g{(const bf16_t*)(a.ws + WS_H), (const bf16_t*)(a.ws + WS_WIN), M, INC, D}; pg8::StaticOrder S; S.init(M, INC, D, gridDim.x, blockIdx.x, REP_GA);
        const int G = (int)gridDim.x, nlast = S.nwg % G, nidle = nlast ? G - nlast : 0; tailconv = nidle >= 32;
        S.rev = tailconv;
        EpiIn E{(bf16_t*)(a.ws + WS_CV), (bf16_t*)(a.ws + WS_BG), (bf16_t*)(a.ws + WS_UB), (const float*)(a.ws + WS_R0), (unsigned*)(a.ws + WS_CTL + CTL_SC), tailconv};
        pg8::gemm_phase<EpiIn, pg8::StaticOrder>(lds, g, S, E);
        { PHASE_IDS; if (tailconv) { if ((int)blockIdx.x >= nlast) { const int j = (int)blockIdx.x - nlast, n2 = (128 - nidle > 0 && 128 - nidle < nidle) ? 128 - nidle : 0;
                if (j >= n2) convert_weights<2>(a, lds, wave, lane, (j - n2) * NWAVES + wave, (nidle - n2) * NWAVES);
                if (t_ == 0) { unsigned sp = 0; const unsigned need = (unsigned)((M - NP) / 256 * (INC / 256) * NWAVES);
                    while (__hip_atomic_load(E.sc, __ATOMIC_RELAXED, __HIP_MEMORY_SCOPE_AGENT) < need) { __builtin_amdgcn_s_sleep(8); if (++sp > (1u << 20)) break; }
                    __builtin_amdgcn_fence(__ATOMIC_ACQUIRE, "agent"); asm volatile("s_waitcnt vmcnt(0)" ::: "memory"); }
                __syncthreads();
                phase_conv(a, lds, wave, lane, 512 + ((int)blockIdx.x - nlast), 640, nidle); } }
          else convert_weights<2>(a, lds, wave, lane, (int)blockIdx.x * NWAVES + wave, G * NWAVES); }
    }
    xcd_barrier<false>(bar);
    STAMP(ts2);
    { PHASE_IDS; phase_conv(a, lds, wave, lane, (int)blockIdx.x, tailconv ? 512 : 640, (int)gridDim.x); }
    xcd_barrier<false>(bar);
    STAMP(ts3);
    {
        pg8::Gemm g{(const bf16_t*)(a.ws + WS_YM), (const bf16_t*)(a.ws + WS_WOUT), M, D, D}; pg8::SplitOrder S; S.init(NP, M, D, D, gridDim.x, blockIdx.x);
        EpiOut E{(const bf16_t*)(a.ws + WS_H), (bf16_t*)(a.ws + WS_X1B), (float*)(a.ws + WS_SS1), (bf16_t*)(a.ws + WS_SLAB)};
        pg8::gemm_phase<EpiOut, pg8::SplitOrder>(lds, g, S, E);
        { PHASE_IDS; const int nidle = (int)gridDim.x - S.nsub; if (nidle >= 64) { if ((int)blockIdx.x >= S.nsub) convert_weights<1>(a, lds, wave, lane, ((int)blockIdx.x - S.nsub) * NWAVES + wave, nidle * NWAVES); }
          else convert_weights<1>(a, lds, wave, lane, (int)blockIdx.x * NWAVES + wave, (int)gridDim.x * NWAVES); }
    }
    xcd_barrier<false>(bar);
    STAMP(ts4);
    { PHASE_IDS; phase_fixup(a, wave, lane); }
    xcd_barrier<false>(bar);
    {
        pg8::Gemm g{(const bf16_t*)(a.ws + WS_X1B), (const bf16_t*)(a.ws + WS_WGU), M, GU, D}; pg8::StaticOrder S; S.init(M, GU, D, gridDim.x, blockIdx.x, REP_GD);
        EpiGU E{(const float*)(a.ws + WS_R), (bf16_t*)(a.ws + WS_F)};
        pg8::gemm_phase<EpiGU, pg8::StaticOrder>(lds, g, S, E);
    }
    xcd_barrier<true>(bar);
    STAMP(ts5);
    {
        pg8::Gemm g{(const bf16_t*)(a.ws + WS_F), (const bf16_t*)(a.ws + WS_WDN), M, D, FF}; pg8::SplitOrder S; S.init(NP, M, D, FF, gridDim.x, blockIdx.x);
        EpiDown E{(const bf16_t*)(a.ws + WS_X1B), a.out + O_Y, (bf16_t*)(a.ws + WS_SLAB), (float*)(a.ws + WS_XS), (unsigned*)(a.ws + WS_CTL + CTL_CNT), a.in[16]};
        pg8::gemm_phase<EpiDown, pg8::SplitOrder>(lds, g, S, E);
    }
    xcd_barrier<true>(bar);
    STAMP(ts6);
    { PHASE_IDS; phase_final(a, lds, wave, lane); }
    if (PROBE_T) {
        asm volatile("s_waitcnt vmcnt(0)" ::: "memory"); __syncthreads();
        STAMP(ts7);
        if (blockIdx.x == 0 && tid == 0) {
            const unsigned long long C[8] = {0, ts1 - ts0, ts2 - ts0, ts3 - ts0, ts4 - ts0, ts5 - ts0, ts6 - ts0, ts7 - ts0};
            const unsigned long long d = 16ull * C[PROBE_T1];
            while (__builtin_amdgcn_s_memrealtime() - ts7 < d) __builtin_amdgcn_s_sleep(32);
        }
    }
}

extern "C" void kernel_launch(void* const* d_in, const int* in_sizes, int n_in, void* d_out, int out_size, void* d_ws, size_t ws_size, hipStream_t stream) {
    static int grid = 0;
    if (grid == 0) {
        if (n_in != 17 || ws_size < WS_END) { fprintf(stderr, "kernel_launch: unexpected n_in %d / ws %zu\n", n_in, ws_size); grid = -1; return; }
        int dev = 0, cus = 0, per_cu = 0;
        if (hipGetDevice(&dev) != hipSuccess || hipDeviceGetAttribute(&cus, hipDeviceAttributeMultiprocessorCount, dev) != hipSuccess) { grid = -1; return; }
        if (hipFuncSetAttribute((const void*)fwd_megakernel, hipFuncAttributeMaxDynamicSharedMemorySize, LDS_BYTES) != hipSuccess) { fprintf(stderr, "kernel_launch: hipFuncSetAttribute failed\n"); grid = -1; return; }
        if (hipOccupancyMaxActiveBlocksPerMultiprocessor(&per_cu, (const void*)fwd_megakernel, NTHREADS, LDS_BYTES) != hipSuccess || per_cu < 1) { fprintf(stderr, "kernel_launch: occupancy query says %d blocks per CU\n", per_cu); grid = -1; (void)hipGetLastError(); return; }
        grid = cus;
    }
    if (grid < 0) return;
    (void)hipMemsetAsync((char*)d_ws + WS_CTL, 0, CTL_BYTES, stream);
    Args a{};
    for (int i = 0; i < 17; ++i) a.in[i] = (const float*)d_in[i];
    a.out = (float*)d_out; a.ws = (unsigned char*)d_ws;
    hipLaunchKernelGGL(fwd_megakernel, dim3(grid), dim3(NTHREADS), LDS_BYTES, stream, a);
}
```

```cpp
#include <hip/hip_runtime.h>
#include <cstdio>

#define LAS __attribute__((address_space(3)))
#define REP_P0 1
#define REP_PB 1
#define REP_GA 1
#define REP_GC 1
#define REP_GD 1
#define REP_GE 1
#define PROBE_T 0
#define PROBE_T1 1
#define PROBE_T2 2
typedef unsigned short bf16_t;
typedef short bf16x8 __attribute__((ext_vector_type(8)));
typedef float f32x4 __attribute__((ext_vector_type(4)));
typedef float f32x2 __attribute__((ext_vector_type(2)));
typedef unsigned u32x4 __attribute__((ext_vector_type(4)));
typedef unsigned u32x2 __attribute__((ext_vector_type(2)));

constexpr int D = 1024, NP = 16384, NS = 1024, M = NP + NS;
constexpr int GW = 512, INC = 2560, FF = 2816, GU = 2 * FF;
constexpr int SEQ = 2048, NB = 8, DSEQ = 8, DB = 128, KA = 3, KB = 31;
constexpr float EPS = 1e-6f;
constexpr size_t O_Y = 0, O_NAP = (size_t)M * D, O_NBP = O_NAP + (size_t)NB * 2 * GW, O_NAS = O_NBP + (size_t)NB * 30 * GW, O_NBS = O_NAS + (size_t)DB * 2 * GW;
constexpr size_t WS_CTL = 0, CTL_BYTES = 65536, CTL_CNT = 16384, CTL_SC = 49152, CTL_YM = 49664;
constexpr size_t WS_WIN = WS_CTL + CTL_BYTES;
constexpr size_t WS_WOUT = WS_WIN + (size_t)INC * D * 2;
constexpr size_t WS_WGU = WS_WOUT + (size_t)D * D * 2;
constexpr size_t WS_WDN = WS_WGU + (size_t)GU * D * 2;
constexpr size_t WS_SS1 = WS_WDN + (size_t)D * FF * 2;
constexpr size_t WS_X1B = WS_SS1 + (size_t)M * 16 * 4;
constexpr size_t WS_R1 = WS_X1B + (size_t)M * D * 2;
constexpr size_t WS_H = WS_R1;
constexpr size_t WS_CV = WS_H + (size_t)M * D * 2;
constexpr size_t WS_BG = WS_CV + (size_t)M * GW * 2;
constexpr size_t WS_UB = WS_BG + (size_t)M * GW * 2;
constexpr size_t WS_YM = WS_UB + (size_t)M * GW * 2;
constexpr size_t WS_F = WS_R1;
constexpr size_t WS_SLAB = WS_YM + (size_t)M * D * 2;
constexpr size_t WS_XS = WS_SLAB + (size_t)11 * NS * D * 4;
constexpr size_t WS_R = WS_XS + (size_t)NP * 16 * 4;
constexpr size_t WS_R0 = WS_R + (size_t)M * 4;
constexpr size_t WS_END = WS_R0 + (size_t)M * 4;
static_assert((size_t)M * FF * 2 <= WS_SLAB - WS_R1, "F overlay");
static_assert((FF / 64) % 4 == 0 && (FF / 64) / 4 == 11 && (D / 64) / 4 == 4, "slab count");
static_assert(WS_END <= (size_t)256 * 1024 * 1024, "workspace");

constexpr int NTHREADS = 512, NWAVES = 8;
constexpr int LDS_BYTES = 144 * 1024, MISC_OFF = LDS_BYTES - 16;
constexpr int SPARE_OFF = 128 * 1024;
constexpr int U_ROWS = 62, CB_OFF = U_ROWS * GW * 4;
static_assert(CB_OFF + 8 * GW * 4 <= MISC_OFF, "lds");

__device__ __forceinline__ unsigned cvt_pk_bf16(float lo, float hi) { unsigned r; asm volatile("v_cvt_pk_bf16_f32 %0, %1, %2" : "=v"(r) : "v"(lo), "v"(hi)); return r; }
__device__ __forceinline__ float bf_lo(unsigned w) { return __uint_as_float(w << 16); }
__device__ __forceinline__ float bf_hi(unsigned w) { return __uint_as_float(w & 0xffff0000u); }
__device__ __forceinline__ float sigmoidf_(float x) { return __builtin_amdgcn_rcpf(1.0f + __expf(-x)); }
__device__ __forceinline__ void st16_wt(void* p, u32x4 v) { asm volatile("global_store_dwordx4 %0, %1, off sc1\n\ts_nop 1" :: "v"(p), "v"(v) : "memory"); }
__device__ __forceinline__ float wave_sum(float v) {
#pragma unroll
    for (int o = 1; o < 64; o <<= 1) v += __shfl_xor(v, o);
    return v;
}

#define XB_TMO      128
#define XB_XCNT(j)  (256  + 64 * (j))
#define XB_XSUB(j)  (1280 + 64 * (j))
#define XB_XGEN(j)  (2304 + 64 * (j))
#define XB_TOP      3328
#define XB_TOPGEN   3392
#define XCD_BAR_WORDS 3456
#define XB_SPIN_CAP (1u << 18)
static_assert(XCD_BAR_WORDS * 4 <= CTL_CNT && CTL_CNT + 128 * 256 <= CTL_BYTES, "ctl");
__device__ __forceinline__ unsigned xb_ld(unsigned* p)              { return __hip_atomic_load(p, __ATOMIC_RELAXED, __HIP_MEMORY_SCOPE_AGENT); }
__device__ __forceinline__ unsigned xb_add(unsigned* p, unsigned v) { return __hip_atomic_fetch_add(p, v, __ATOMIC_RELAXED, __HIP_MEMORY_SCOPE_AGENT); }
__device__ __forceinline__ unsigned xb_xcc_id() { return (unsigned)__builtin_amdgcn_s_getreg((3 << 11) | 20) & 0xFu; }
#define XB_SPIN(cond, bar) do { unsigned _sp = 0; while (cond) { __builtin_amdgcn_s_sleep(1); \
    if ((++_sp & 255u) == 0u) { if (xb_ld(&(bar)[XB_TMO])) break; if (_sp > XB_SPIN_CAP) { atomicAdd(&(bar)[XB_TMO], 1u); break; } } } } while (0)
struct XcdBarrier { unsigned* bar; unsigned x; volatile LAS unsigned* st; };
__device__ __forceinline__ XcdBarrier xcd_barrier_post(unsigned* bar, volatile LAS unsigned* st) {
    XcdBarrier b; b.bar = bar; b.x = xb_xcc_id(); b.st = st;
    if (threadIdx.x == 0) (void)xb_add(&bar[XB_XCNT(b.x)], 1u);
    return b;
}
__device__ __forceinline__ void xcd_barrier_complete(unsigned* bar, unsigned x, unsigned& nloc, unsigned& nx) {
    const unsigned G = gridDim.x * gridDim.y * gridDim.z;
    unsigned sum, cnt, mine, sp = 0u;
    for (;;) {
        sum = 0u; cnt = 0u; mine = 0u;
#pragma unroll
        for (unsigned j = 0; j < 16; ++j) { const unsigned c = xb_ld(&bar[XB_XCNT(j)]); sum += c; cnt += (c > 0u) ? 1u : 0u; mine = (j == x) ? c : mine; }
        if (sum == G) break;
        __builtin_amdgcn_s_sleep(1);
        if ((++sp & 255u) == 0u) { if (xb_ld(&bar[XB_TMO])) break; if (sp > XB_SPIN_CAP) { atomicAdd(&bar[XB_TMO], 1u); break; } }
    }
    nloc = mine > 0u ? mine : 1u; nx = cnt > 0u ? cnt : 1u;
}
template <bool ACQ = true>
__device__ __forceinline__ void xcd_barrier(const XcdBarrier& b) {
    asm volatile("s_waitcnt vmcnt(0)" ::: "memory");
    __syncthreads();
    if (threadIdx.x == 0) {
        unsigned* bar = b.bar;
        __builtin_amdgcn_s_waitcnt(0);
        unsigned nloc = b.st[0], nx = b.st[1];
        if (nloc == 0u) { xcd_barrier_complete(bar, b.x, nloc, nx); b.st[0] = nloc; b.st[1] = nx; }
        const unsigned bg = b.st[2];
        const unsigned old = xb_add(&bar[XB_XSUB(b.x)], 1u);
        const unsigned gen = old / nloc;
        bool released = false;
        if (old + 1u == (gen + 1u) * nloc) {
            __builtin_amdgcn_fence(__ATOMIC_RELEASE, "agent");
            asm volatile("s_waitcnt vmcnt(0)" ::: "memory");
            const unsigned og = xb_add(&bar[XB_TOP], 1u);
            const unsigned tg = og / nx;
            if (og + 1u == (tg + 1u) * nx) { xb_add(&bar[XB_TOPGEN], 1u); released = true; }
        }
        if (!released) XB_SPIN(xb_ld(&bar[XB_TOPGEN]) == bg, bar);
        b.st[2] = bg + 1u;
        if (ACQ) { __builtin_amdgcn_fence(__ATOMIC_ACQUIRE, "agent"); asm volatile("s_waitcnt vmcnt(0)" ::: "memory"); }
    }
    asm volatile("" ::: "memory");
    __syncthreads();
}

namespace pg8 {
constexpr int BM = 256, BK = 64, HALF = 128, HTB = HALF * BK * 2, STAGE_BYTES = 8 * HTB, NXCD = 8, WGM = 8;
__host__ __device__ __forceinline__ int lds_byte(int r, int c) { const int st = (r >> 4) * 2 + (c >> 5), rr = r & 15, cc = c & 31, ob = rr * 64 + cc * 2; return st * 1024 + (ob ^ (((ob >> 9) & 1) << 5)); }
__host__ __device__ __forceinline__ void stage_rc(int b, int& R, int& C) { const int st = b / 1024, sb = b % 1024, swz = sb ^ (((sb >> 9) & 1) << 5); R = (st >> 1) * 16 + swz / 64; C = (st & 1) * 32 + (swz % 64) / 2; }
__host__ __device__ __forceinline__ int perm32(int rho) { const int n = rho >> 4, i = rho & 15; return 8 * (i >> 2) + 4 * n + (i & 3); }
struct Unit { int pm, pn, kt0, nt, sub; };
struct Gemm { const bf16_t* A; const bf16_t* Bt; int M, N, K; };
struct StaticOrder {
    int nM, nN, nwg, G, c, rep, ntk; bool rev = false;
    __host__ __device__ void init(int M_, int N_, int K_, int G_, int c_, int rep_ = 1) { nM = M_ / BM; nN = N_ / BM; nwg = nM * nN; G = G_; c = c_; rep = rep_; ntk = K_ / BK; }
    __host__ __device__ bool next(int i, Unit& u) const {
        if (rep > 1) { const int rounds = (nwg - c + G - 1) / G; if (i >= rounds * rep) return false; i = i % rounds; }
        const long L = (long)i * G + c; if (L >= nwg) return false;
        int wgid = (int)L; { const int q = nwg / NXCD, r = nwg % NXCD, xcd = wgid % NXCD, off = wgid / NXCD; wgid = (xcd < r ? xcd * (q + 1) : r * (q + 1) + (xcd - r) * q) + off; }
        if (rev) wgid = nwg - 1 - wgid;
        const int nig = WGM * nN, gid = wgid / nig, fm = gid * WGM, gsz = (nM - fm) < WGM ? (nM - fm) : WGM;
        u.pm = fm + ((wgid % nig) % gsz); u.pn = (wgid % nig) / gsz; u.kt0 = 0; u.nt = ntk; u.sub = 0; return true;
    }
};
struct SplitOrder {
    StaticOrder base; int nfull, nsub, nslice, pm0, nNs;
    static constexpr int SUBK = 4;
    __host__ __device__ void init(int Mfull, int Mtot, int N_, int K_, int G_, int c_) { base.init(Mfull, N_, K_, G_, c_); nfull = (base.nwg - c_ + G_ - 1) / G_; if (nfull < 0) nfull = 0;
        nslice = (K_ / BK) / SUBK; nNs = N_ / BM; pm0 = Mfull / BM; nsub = ((Mtot - Mfull) / BM) * nNs * nslice; }
    __host__ __device__ bool next(int i, Unit& u) const {
        if (i < nfull) return base.next(i, u);
        const long s = (long)(i - nfull) * base.G + base.c; if (s >= nsub) return false;
        const int lu = (int)s / nslice, ks = (int)s % nslice;
        u.pm = pm0 + lu / nNs; u.pn = lu % nNs; u.kt0 = ks * SUBK; u.nt = SUBK; u.sub = 1; return true;
    }
};
template <class Epi, class Sched>
__device__ __forceinline__ void gemm_phase(LAS unsigned char* lds, const Gemm g, const Sched& S, const Epi& E) {
    const int tid = threadIdx.x, wid = __builtin_amdgcn_readfirstlane(tid >> 6), lane = tid & 63, wr = wid >> 2, wc = wid & 3, fr = lane & 15, fq = lane >> 4;
    const int K = g.K;
    unsigned voffA[2], voffB[2];
#pragma unroll
    for (int i = 0; i < 2; ++i) { int R, C; stage_rc(tid * 16 + i * 8192, R, C); const int Rb = Epi::PERM ? ((R & ~31) + perm32(R & 31)) : R;
        voffA[i] = (unsigned)(R * K + C) * 2u; voffB[i] = (unsigned)(Rb * K + C) * 2u; }
    const size_t kstep = (size_t)(BK * 2);
    const size_t hstep = (size_t)HALF * K * 2;
    const size_t tstep = 2 * hstep;
    const unsigned ldsw = (unsigned)wid * 1024u;
    const int aoff = lds_byte(wr * 64 + fr, fq * 8), boff = lds_byte(wc * 32 + fr, fq * 8);
#define PG8_SA(b, h) (((b) * 2 + (h)) * HTB)
#define PG8_SB(b, h) ((4 + (b) * 2 + (h)) * HTB)
#define PG8_STAGE(bufoff, gbase, voff) do { _Pragma("unroll") for (int _i = 0; _i < 2; ++_i) \
        __builtin_amdgcn_global_load_lds((const unsigned*)((const char*)(gbase) + (voff)[_i]), (LAS unsigned*)(lds + (bufoff) + ldsw + _i * 8192), 16, 0, 0); } while (0)
#define PG8_LDA(dst, b, h) do { _Pragma("unroll") for (int m = 0; m < 4; ++m) _Pragma("unroll") for (int k = 0; k < 2; ++k) dst[m][k] = *(const LAS bf16x8*)(lds + PG8_SA(b, h) + aoff + m * 2048 + k * 1024); } while (0)
#define PG8_LDB(dst, b, h) do { _Pragma("unroll") for (int n = 0; n < 2; ++n) _Pragma("unroll") for (int k = 0; k < 2; ++k) dst[n][k] = *(const LAS bf16x8*)(lds + PG8_SB(b, h) + boff + n * 2048 + k * 1024); } while (0)
#define PG8_MMA(ai, bj, At, Bt) do { __builtin_amdgcn_s_setprio(1); _Pragma("unroll") for (int m = 0; m < 4; ++m) _Pragma("unroll") for (int n = 0; n < 2; ++n) _Pragma("unroll") for (int k = 0; k < 2; ++k) \
        acc[ai][bj][m][n] = __builtin_amdgcn_mfma_f32_16x16x32_bf16(Bt[n][k], At[m][k], acc[ai][bj][m][n], 0, 0, 0); __builtin_amdgcn_s_setprio(0); } while (0)
#define PG8_WAIT_V(n) asm volatile("s_waitcnt vmcnt(" #n ")" ::: "memory")
#define PG8_WAIT_L(n) asm volatile("s_waitcnt lgkmcnt(" #n ")" ::: "memory")
#define PG8_BAR __builtin_amdgcn_s_barrier()
#define PG8_SCHED __builtin_amdgcn_sched_barrier(0)
    Unit cur, nxt; int ui = 0;
    if (!S.next(0, cur)) return;
    f32x4 acc[2][2][4][2];
#pragma unroll
    for (int a = 0; a < 2; ++a)
#pragma unroll
        for (int b = 0; b < 2; ++b)
#pragma unroll
            for (int m = 0; m < 4; ++m)
#pragma unroll
                for (int n = 0; n < 2; ++n) acc[a][b][m][n] = (f32x4){0.f, 0.f, 0.f, 0.f};
    bf16x8 At[4][2], B0[2][2], B1[2][2];
    const char* cA = (const char*)g.A + (size_t)cur.pm * tstep + (size_t)cur.kt0 * kstep; const char* cB = (const char*)g.Bt + (size_t)cur.pn * tstep + (size_t)cur.kt0 * kstep;
    PG8_STAGE(PG8_SB(0, 0), cB, voffB); PG8_STAGE(PG8_SA(0, 0), cA, voffA); PG8_STAGE(PG8_SB(0, 1), cB + hstep, voffB); PG8_STAGE(PG8_SA(0, 1), cA + hstep, voffA);
    if (wr == 1) PG8_BAR;
    PG8_WAIT_V(4); PG8_BAR;
    PG8_STAGE(PG8_SB(1, 0), cB + kstep, voffB); PG8_STAGE(PG8_SA(1, 0), cA + kstep, voffA); PG8_STAGE(PG8_SB(1, 1), cB + hstep + kstep, voffB);
    PG8_WAIT_V(6); PG8_BAR;
    for (;;) {
        const bool has_next = S.next(ui + 1, nxt);
        const char* nA = has_next ? (const char*)g.A + (size_t)nxt.pm * tstep + (size_t)nxt.kt0 * kstep : cA; const char* nB = has_next ? (const char*)g.Bt + (size_t)nxt.pn * tstep + (size_t)nxt.kt0 * kstep : cB;
        const int nt = cur.nt;
        for (int t = 0; t < nt; t += 2) {
            const bool last = (t == nt - 2);
            const char* a1 = cA + (size_t)(t + 1) * kstep;
            const char* a2 = last ? nA : cA + (size_t)(t + 2) * kstep; const char* b2 = last ? nB : cB + (size_t)(t + 2) * kstep;
            const char* a3 = a2 + kstep; const char* b3 = b2 + kstep;
            if (last) E.pre(lds, cur, wid, wr, lane);
            PG8_LDB(B0, 0, 0); PG8_SCHED; PG8_LDA(At, 0, 0); PG8_STAGE(PG8_SA(1, 1), a1 + hstep, voffA);
            PG8_WAIT_L(8); PG8_BAR; PG8_WAIT_L(0); PG8_MMA(0, 0, At, B0); PG8_BAR; PG8_SCHED;
            PG8_LDB(B1, 0, 1); PG8_STAGE(PG8_SB(0, 0), b2, voffB);
            PG8_BAR; PG8_WAIT_L(0); PG8_MMA(0, 1, At, B1); PG8_BAR;
            PG8_LDA(At, 0, 1); PG8_STAGE(PG8_SA(0, 0), a2, voffA);
            PG8_BAR; PG8_WAIT_L(0); PG8_MMA(1, 0, At, B0); PG8_BAR; PG8_SCHED;
            PG8_STAGE(PG8_SB(0, 1), b2 + hstep, voffB);
            PG8_WAIT_V(6); PG8_BAR; PG8_MMA(1, 1, At, B1); PG8_BAR;
            PG8_LDB(B0, 1, 0); PG8_SCHED; PG8_LDA(At, 1, 0); PG8_STAGE(PG8_SA(0, 1), a2 + hstep, voffA);
            PG8_WAIT_L(8); PG8_BAR; PG8_WAIT_L(0); PG8_MMA(0, 0, At, B0); PG8_BAR; PG8_SCHED;
            PG8_LDB(B1, 1, 1); PG8_STAGE(PG8_SB(1, 0), b3, voffB);
            PG8_BAR; PG8_WAIT_L(0); PG8_MMA(0, 1, At, B1); PG8_BAR;
            PG8_LDA(At, 1, 1); PG8_STAGE(PG8_SA(1, 0), a3, voffA);
            PG8_BAR; PG8_WAIT_L(0); PG8_MMA(1, 0, At, B0); PG8_BAR; PG8_SCHED;
            PG8_STAGE(PG8_SB(1, 1), b3 + hstep, voffB);
            PG8_WAIT_V(6); PG8_BAR; PG8_MMA(1, 1, At, B1); PG8_BAR;
        }
        if (wr == 0) PG8_BAR;
        E(acc, cur, wr, wc, fr, fq, lds);
        if (!has_next) break;
        if (wr == 1) PG8_BAR;
#pragma unroll
        for (int a = 0; a < 2; ++a)
#pragma unroll
            for (int b = 0; b < 2; ++b)
#pragma unroll
                for (int m = 0; m < 4; ++m)
#pragma unroll
                    for (int n = 0; n < 2; ++n) acc[a][b][m][n] = (f32x4){0.f, 0.f, 0.f, 0.f};
        cur = nxt; cA = nA; cB = nB; ++ui;
    }
    PG8_WAIT_V(0);
    PG8_BAR;
#undef PG8_SA
#undef PG8_SB
#undef PG8_STAGE
#undef PG8_LDA
#undef PG8_LDB
#undef PG8_MMA
#undef PG8_WAIT_V
#undef PG8_WAIT_L
#undef PG8_BAR
#undef PG8_SCHED
}
}
using pg8::Unit; using pg8::HALF;

struct EpiIn {
    static constexpr bool PERM = true;
    bf16_t *CV, *BG, *UB; const float* R0; unsigned* sc; bool handoff;
    __device__ __forceinline__ void pre(LAS unsigned char* lds, const Unit& u, int wid, int wr, int lane) const {
        const float* rp = R0 + u.pm * 256 + wr * 64 + lane;
#pragma unroll
        for (int ai = 0; ai < 2; ++ai) __builtin_amdgcn_global_load_lds((const unsigned*)(rp + ai * HALF), (LAS unsigned*)(lds + SPARE_OFF + wid * 512 + ai * 256), 4, 0, 0);
    }
    __device__ __forceinline__ void operator()(const f32x4 (&acc)[2][2][4][2], const Unit& u, int wr, int wc, int fr, int fq, LAS unsigned char* lds) const {
        const int row0 = u.pm * 256 + wr * 64 + fr; const bool wt = handoff && u.pm >= NP / 256;
        const LAS float* rl_ = (const LAS float*)(lds + SPARE_OFF + (wr * 4 + wc) * 512);
        if (u.pn == 4 || u.pn == 5) {
            const int col0 = (u.pn - 4) * 256 + wc * 32 + 8 * fq;
#pragma unroll
            for (int ai = 0; ai < 2; ++ai)
#pragma unroll
                for (int m = 0; m < 4; ++m) { bf16_t* rowp = BG + (size_t)(row0 + ai * HALF + m * 16) * GW + col0; const float r = rl_[ai * 64 + m * 16 + fr];
#pragma unroll
                    for (int bj = 0; bj < 2; ++bj) { const f32x4 v0 = acc[ai][bj][m][0] * r, v1 = acc[ai][bj][m][1] * r;
                        u32x4 w; w.x = cvt_pk_bf16(v0[0], v0[1]); w.y = cvt_pk_bf16(v0[2], v0[3]); w.z = cvt_pk_bf16(v1[0], v1[1]); w.w = cvt_pk_bf16(v1[2], v1[3]);
                        if (wt) st16_wt(rowp + bj * HALF, w); else *(u32x4*)(rowp + bj * HALF) = w; } }
        } else {
            const bool glu = u.pn >= 6; bf16_t* base = glu ? UB : CV; const int pq = glu ? u.pn - 6 : u.pn;
            const int col0 = pq * 128 + wc * 32 + 8 * fq;
#pragma unroll
            for (int ai = 0; ai < 2; ++ai)
#pragma unroll
                for (int m = 0; m < 4; ++m) { bf16_t* rowp = base + (size_t)(row0 + ai * HALF + m * 16) * GW + col0; const float r = rl_[ai * 64 + m * 16 + fr], r2 = r * r;
                    float o[8];
#pragma unroll
                    for (int n = 0; n < 2; ++n)
#pragma unroll
                        for (int j = 0; j < 4; ++j) { const float av = acc[ai][0][m][n][j], gt = acc[ai][1][m][n][j]; o[n * 4 + j] = glu ? (av * r) * sigmoidf_(gt * r) : (av * gt) * r2; }
                    u32x4 w; w.x = cvt_pk_bf16(o[0], o[1]); w.y = cvt_pk_bf16(o[2], o[3]); w.z = cvt_pk_bf16(o[4], o[5]); w.w = cvt_pk_bf16(o[6], o[7]);
                    if (wt) st16_wt(rowp, w); else *(u32x4*)rowp = w; }
        }
        if (wt) { asm volatile("s_waitcnt vmcnt(0)" ::: "memory");
            if ((threadIdx.x & 63) == 0) __hip_atomic_fetch_add(sc, 1u, __ATOMIC_RELAXED, __HIP_MEMORY_SCOPE_AGENT); }
    }
};
struct EpiOut {
    static constexpr bool PERM = true;
    const bf16_t* XB; bf16_t* X1B; float* SS; bf16_t* SLAB;
    __device__ __forceinline__ void pre(LAS unsigned char*, const Unit&, int, int, int) const {}
    __device__ __forceinline__ void operator()(const f32x4 (&acc)[2][2][4][2], const Unit& u, int wr, int wc, int fr, int fq, LAS unsigned char* lds) const {
        const int row0 = u.pm * 256 + wr * 64 + fr, col0 = u.pn * 256 + wc * 32 + 8 * fq;
        if (u.sub) {
            bf16_t* sl = SLAB + (size_t)(u.kt0 / pg8::SplitOrder::SUBK) * NS * D - (size_t)NP * D;
#pragma unroll
            for (int ai = 0; ai < 2; ++ai)
#pragma unroll
                for (int m = 0; m < 4; ++m) { bf16_t* orow = sl + (size_t)(row0 + ai * HALF + m * 16) * D + col0;
#pragma unroll
                    for (int bj = 0; bj < 2; ++bj) { const f32x4 v0 = acc[ai][bj][m][0], v1 = acc[ai][bj][m][1];
                        u32x4 w; w.x = cvt_pk_bf16(v0[0], v0[1]); w.y = cvt_pk_bf16(v0[2], v0[3]); w.z = cvt_pk_bf16(v1[0], v1[1]); w.w = cvt_pk_bf16(v1[2], v1[3]);
                        *(u32x4*)(orow + bj * HALF) = w; } }
            return;
        }
#pragma unroll
        for (int ai = 0; ai < 2; ++ai) {
            u32x4 xw[4][2];
#pragma unroll
            for (int m = 0; m < 4; ++m) { const bf16_t* xr = XB + (size_t)(row0 + ai * HALF + m * 16) * D + col0; xw[m][0] = *(const u32x4*)xr; xw[m][1] = *(const u32x4*)(xr + HALF); }
#pragma unroll
            for (int m = 0; m < 4; ++m) { const int row = row0 + ai * HALF + m * 16; bf16_t* orow = X1B + (size_t)row * D + col0;
                float ss = 0.f;
#pragma unroll
                for (int bj = 0; bj < 2; ++bj) { const u32x4 q = xw[m][bj];
                    const f32x4 x0 = {bf_lo(q.x), bf_hi(q.x), bf_lo(q.y), bf_hi(q.y)}, x1 = {bf_lo(q.z), bf_hi(q.z), bf_lo(q.w), bf_hi(q.w)};
                    const f32x4 v0 = acc[ai][bj][m][0] + x0, v1 = acc[ai][bj][m][1] + x1;
                    ss += (v0[0] * v0[0] + v0[1] * v0[1]) + (v0[2] * v0[2] + v0[3] * v0[3]) + (v1[0] * v1[0] + v1[1] * v1[1]) + (v1[2] * v1[2] + v1[3] * v1[3]);
                    u32x4 w; w.x = cvt_pk_bf16(v0[0], v0[1]); w.y = cvt_pk_bf16(v0[2], v0[3]); w.z = cvt_pk_bf16(v1[0], v1[1]); w.w = cvt_pk_bf16(v1[2], v1[3]);
                    *(u32x4*)(orow + bj * HALF) = w; }
                ss += __shfl_xor(ss, 16); ss += __shfl_xor(ss, 32);
                if (fq == 0) SS[(size_t)row * 16 + u.pn * 4 + wc] = ss; }
            asm volatile("" ::: "memory"); }
    }
};
struct EpiGU {
    static constexpr bool PERM = true;
    const float* R; bf16_t* F;
    __device__ __forceinline__ void pre(LAS unsigned char* lds, const Unit& u, int wid, int wr, int lane) const {
        const float* rp = R + u.pm * 256 + wr * 64 + lane;
#pragma unroll
        for (int ai = 0; ai < 2; ++ai) __builtin_amdgcn_global_load_lds((const unsigned*)(rp + ai * HALF), (LAS unsigned*)(lds + SPARE_OFF + wid * 512 + ai * 256), 4, 0, 0);
    }
    __device__ __forceinline__ void operator()(const f32x4 (&acc)[2][2][4][2], const Unit& u, int wr, int wc, int fr, int fq, LAS unsigned char* lds) const {
        const LAS float* rl_ = (const LAS float*)(lds + SPARE_OFF + (wr * 4 + wc) * 512);
        const int row0 = u.pm * 256 + wr * 64 + fr, col0 = u.pn * 128 + wc * 32 + 8 * fq;
#pragma unroll
        for (int ai = 0; ai < 2; ++ai)
#pragma unroll
            for (int m = 0; m < 4; ++m) { const int row = row0 + ai * HALF + m * 16; const float r = rl_[ai * 64 + m * 16 + fr]; const f32x2 r2 = {r, r}, rl = {r * -1.4426950409f, r * -1.4426950409f};
                f32x2 o[4];
#pragma unroll
                for (int n = 0; n < 2; ++n)
#pragma unroll
                    for (int jp = 0; jp < 2; ++jp) { const f32x2 ga = {acc[ai][0][m][n][2 * jp], acc[ai][0][m][n][2 * jp + 1]}, ua = {acc[ai][1][m][n][2 * jp], acc[ai][1][m][n][2 * jp + 1]};
                        const f32x2 t = ga * rl; f32x2 e; e.x = __builtin_amdgcn_exp2f(t.x); e.y = __builtin_amdgcn_exp2f(t.y);
                        const f32x2 d = e + 1.0f; f32x2 sg; sg.x = __builtin_amdgcn_rcpf(d.x); sg.y = __builtin_amdgcn_rcpf(d.y);
                        o[n * 2 + jp] = ((ga * r2) * sg) * (ua * r2); }
                u32x4 w; w.x = cvt_pk_bf16(o[0].x, o[0].y); w.y = cvt_pk_bf16(o[1].x, o[1].y); w.z = cvt_pk_bf16(o[2].x, o[2].y); w.w = cvt_pk_bf16(o[3].x, o[3].y);
                *(u32x4*)(F + (size_t)row * FF + col0) = w; }
    }
};
struct EpiDown {
    static constexpr bool PERM = true;
    const bf16_t* X1B; float* Y; bf16_t* SLAB; float* XS; unsigned* cnt; const float* gfin;
    __device__ __forceinline__ void pre(LAS unsigned char*, const Unit&, int, int, int) const {}
    __device__ __forceinline__ void operator()(f32x4 (&acc)[2][2][4][2], const Unit& u, int wr, int wc, int fr, int fq, LAS unsigned char* lds) const {
        const int row0 = u.pm * 256 + wr * 64 + fr, col0 = u.pn * 256 + wc * 32 + 8 * fq;
        if (u.sub) {
            bf16_t* sl = SLAB + (size_t)(u.kt0 / pg8::SplitOrder::SUBK) * NS * D - (size_t)NP * D;
#pragma unroll
            for (int ai = 0; ai < 2; ++ai)
#pragma unroll
                for (int m = 0; m < 4; ++m) { bf16_t* orow = sl + (size_t)(row0 + ai * HALF + m * 16) * D + col0;
#pragma unroll
                    for (int bj = 0; bj < 2; ++bj) { const f32x4 v0 = acc[ai][bj][m][0], v1 = acc[ai][bj][m][1];
                        u32x4 w; w.x = cvt_pk_bf16(v0[0], v0[1]); w.y = cvt_pk_bf16(v0[2], v0[3]); w.z = cvt_pk_bf16(v1[0], v1[1]); w.w = cvt_pk_bf16(v1[2], v1[3]);
                        *(u32x4*)(orow + bj * HALF) = w; } }
            return;
        }
#pragma unroll
        for (int ai = 0; ai < 2; ++ai) {
            u32x4 xw[4][2];
#pragma unroll
            for (int m = 0; m < 4; ++m) { const bf16_t* xr = X1B + (size_t)(row0 + ai * HALF + m * 16) * D + col0; xw[m][0] = *(const u32x4*)xr; xw[m][1] = *(const u32x4*)(xr + HALF); }
#pragma unroll
            for (int m = 0; m < 4; ++m) { const int row = row0 + ai * HALF + m * 16;
                float ss = 0.f;
#pragma unroll
                for (int bj = 0; bj < 2; ++bj) { const u32x4 q = xw[m][bj];
                    const f32x4 x0 = {bf_lo(q.x), bf_hi(q.x), bf_lo(q.y), bf_hi(q.y)}, x1 = {bf_lo(q.z), bf_hi(q.z), bf_lo(q.w), bf_hi(q.w)};
                    const f32x4 v0 = acc[ai][bj][m][0] + x0, v1 = acc[ai][bj][m][1] + x1; acc[ai][bj][m][0] = v0; acc[ai][bj][m][1] = v1;
                    ss += (v0[0] * v0[0] + v0[1] * v0[1]) + (v0[2] * v0[2] + v0[3] * v0[3]) + (v1[0] * v1[0] + v1[1] * v1[1]) + (v1[2] * v1[2] + v1[3] * v1[3]); }
                ss += __shfl_xor(ss, 16); ss += __shfl_xor(ss, 32);
                if (fq == 0) __hip_atomic_store(XS + (size_t)row * 16 + u.pn * 4 + wc, ss, __ATOMIC_RELAXED, __HIP_MEMORY_SCOPE_AGENT);
            }
            asm volatile("" ::: "memory"); }
        asm volatile("s_waitcnt vmcnt(0)" ::: "memory");
        unsigned* cw = cnt + 64 * (u.pm * 2 + wr);
        if ((threadIdx.x & 63) == 0) __hip_atomic_fetch_add(cw, 1u, __ATOMIC_RELAXED, __HIP_MEMORY_SCOPE_AGENT);
        { unsigned sp = 0;
          while ((unsigned)__builtin_amdgcn_readfirstlane(__hip_atomic_load(cw, __ATOMIC_RELAXED, __HIP_MEMORY_SCOPE_AGENT)) < 16u) { __builtin_amdgcn_s_sleep(2); if (++sp > (1u << 16)) break; } }
        asm volatile("" ::: "memory");
        f32x4 g0[2], g1[2];
#pragma unroll
        for (int bj = 0; bj < 2; ++bj) { g0[bj] = *(const f32x4*)(gfin + col0 + bj * HALF); g1[bj] = *(const f32x4*)(gfin + col0 + bj * HALF + 4); }
        float tq[2][4];
#pragma unroll
        for (int ai = 0; ai < 2; ++ai)
#pragma unroll
            for (int m = 0; m < 4; ++m) { const float* xs = XS + (size_t)(row0 + ai * HALF + m * 16) * 16 + fq * 4;
                tq[ai][m] = (__hip_atomic_load(xs, __ATOMIC_RELAXED, __HIP_MEMORY_SCOPE_AGENT) + __hip_atomic_load(xs + 1, __ATOMIC_RELAXED, __HIP_MEMORY_SCOPE_AGENT))
                          + (__hip_atomic_load(xs + 2, __ATOMIC_RELAXED, __HIP_MEMORY_SCOPE_AGENT) + __hip_atomic_load(xs + 3, __ATOMIC_RELAXED, __HIP_MEMORY_SCOPE_AGENT)); }
#pragma unroll
        for (int ai = 0; ai < 2; ++ai)
#pragma unroll
            for (int m = 0; m < 4; ++m) { const int row = row0 + ai * HALF + m * 16;
                float t = tq[ai][m]; t += __shfl_xor(t, 16); t += __shfl_xor(t, 32);
                const float r = __builtin_amdgcn_rsqf(t * (1.0f / D) + EPS);
                float* orow = Y + (size_t)row * D + col0;
#pragma unroll
                for (int bj = 0; bj < 2; ++bj) { *(f32x4*)(orow + bj * HALF) = acc[ai][bj][m][0] * r * g0[bj]; *(f32x4*)(orow + bj * HALF + 4) = acc[ai][bj][m][1] * r * g1[bj]; } }
    }
};

struct Args {
    const float* in[17];
    float* out; unsigned char* ws;
};

__device__ __forceinline__ void p0_transpose_item(const float* W, int ldw, int col0, int k0, bf16_t* WT, int K, int drow0, const float* kscale, LAS float* scr, int lane) {
    float tv[32];
#pragma unroll
    for (int i = 0; i < 32; ++i) { const int kk = 2 * i + (lane >> 5); tv[i] = __builtin_nontemporal_load(W + (size_t)(k0 + kk) * ldw + col0 + (lane & 31)); }
    if (kscale) {
#pragma unroll
        for (int i = 0; i < 32; ++i) tv[i] *= kscale[k0 + 2 * i + (lane >> 5)]; }
#pragma unroll
    for (int i = 0; i < 32; ++i) scr[(2 * i + (lane >> 5)) * 33 + (lane & 31)] = tv[i];
    asm volatile("s_waitcnt lgkmcnt(0)" ::: "memory");
    const int c = lane & 7;
#pragma unroll
    for (int j = 0; j < 4; ++j) { const int n = (lane >> 3) + 8 * j; const LAS float* s = scr + (8 * c) * 33 + n;
        u32x4 o; o.x = cvt_pk_bf16(s[0 * 33], s[1 * 33]); o.y = cvt_pk_bf16(s[2 * 33], s[3 * 33]); o.z = cvt_pk_bf16(s[4 * 33], s[5 * 33]); o.w = cvt_pk_bf16(s[6 * 33], s[7 * 33]);
        *(u32x4*)(WT + (size_t)(drow0 + n) * K + k0 + 8 * c) = o; }
    asm volatile("s_waitcnt lgkmcnt(0)" ::: "memory");
}
__device__ __forceinline__ const float* xrow_ptr(const float* xp, const float* xs, int m) { return m < NP ? xp + (size_t)m * D : xs + (size_t)(m - NP) * D; }

template <int WHICH>
__device__ __forceinline__ void convert_weights(const Args& a, LAS unsigned char* lds, int wave, int lane, int gw, int NGW) {
    LAS float* scr = (LAS float*)(lds + wave * 16384);
    const float *w_in = a.in[5], *w_out = a.in[11], *g_ffn = a.in[12], *w_gate = a.in[13], *w_up = a.in[14], *w_down = a.in[15];
    bf16_t* WIN = (bf16_t*)(a.ws + WS_WIN); bf16_t* WOUT = (bf16_t*)(a.ws + WS_WOUT); bf16_t* WGU = (bf16_t*)(a.ws + WS_WGU); bf16_t* WDN = (bf16_t*)(a.ws + WS_WDN);
    constexpr int I_IN = (D / 64) * (INC / 32), I_OUT = (D / 64) * (D / 32), I_GU = (D / 64) * (GU / 32), I_DN = (FF / 64) * (D / 32);
    constexpr int NITEMS = WHICH == 0 ? I_IN + I_OUT : (WHICH == 1 ? I_GU : I_DN);
    for (int it = gw; it < NITEMS; it += NGW) {
        int r = it;
        if (WHICH == 0) {
            if (r < I_IN) { const int nblk = INC / 32, kb = r / nblk, R0 = (r % nblk) * 32;
                int col;
                if (R0 < 1024) { const int pn = R0 >> 8, w = R0 & 255; col = ((w < 128) ? 512 : 1024) + 128 * pn + (w & 127); }
                else if (R0 < 1536) col = R0 - 1024;
                else { const int q = R0 - 1536, pn = q >> 8, w = q & 255; col = ((w < 128) ? 1536 : 2048) + 128 * pn + (w & 127); }
                p0_transpose_item(w_in, INC, col, kb * 64, WIN, D, R0, a.in[4], scr, lane); continue; }
            r -= I_IN;
            { const int nblk = D / 32, kb = r / nblk, R0 = (r % nblk) * 32; p0_transpose_item(w_out, D, R0, kb * 64, WOUT, D, R0, nullptr, scr, lane); }
        } else if (WHICH == 1) {
            const int nblk = GU / 32, kb = r / nblk, R0 = (r % nblk) * 32; const int pn = R0 >> 8, w = R0 & 255;
            p0_transpose_item((w < 128) ? w_gate : w_up, FF, 128 * pn + (w & 127), kb * 64, WGU, D, R0, g_ffn, scr, lane);
        } else {
            const int nblk = D / 32, kb = r / nblk, R0 = (r % nblk) * 32; p0_transpose_item(w_down, D, R0, kb * 64, WDN, FF, R0, nullptr, scr, lane);
        }
    }
}
__device__ __forceinline__ void phase0(const Args& a, LAS unsigned char* lds, int wave, int lane) {
    const int gw = blockIdx.x * NWAVES + wave, NGW = gridDim.x * NWAVES;
    convert_weights<0>(a, lds, wave, lane, gw, NGW);
    bf16_t* H = (bf16_t*)(a.ws + WS_H); float* R0 = (float*)(a.ws + WS_R0);
    for (int m0 = gw; m0 < M; m0 += 4 * NGW) {
        f32x4 v[4][4]; float ss[4];
#pragma unroll
        for (int q = 0; q < 4; ++q) { const int m = (m0 + q * NGW < M) ? m0 + q * NGW : m0; const f32x4* xr = (const f32x4*)xrow_ptr(a.in[0], a.in[1], m) + lane;
#pragma unroll
            for (int j = 0; j < 4; ++j) v[q][j] = __builtin_nontemporal_load(xr + 64 * j); }
#pragma unroll
        for (int q = 0; q < 4; ++q) { float s = 0.f; const int m = m0 + q * NGW;
#pragma unroll
            for (int j = 0; j < 4; ++j) s += (v[q][j].x * v[q][j].x + v[q][j].y * v[q][j].y) + (v[q][j].z * v[q][j].z + v[q][j].w * v[q][j].w);
            ss[q] = s;
            if (m < M) { u32x2* o8 = (u32x2*)(H + (size_t)m * D) + lane;
#pragma unroll
                for (int j = 0; j < 4; ++j) { u32x2 w; w.x = cvt_pk_bf16(v[q][j].x, v[q][j].y); w.y = cvt_pk_bf16(v[q][j].z, v[q][j].w); o8[64 * j] = w; } } }
#pragma unroll
        for (int o = 1; o < 64; o <<= 1) {
#pragma unroll
            for (int q = 0; q < 4; ++q) ss[q] += __shfl_xor(ss[q], o); }
#pragma unroll
        for (int q = 0; q < 4; ++q) { const int m = m0 + q * NGW; if (m < M && lane == 0) R0[m] = __builtin_amdgcn_rsqf(ss[q] * (1.f / D) + EPS); }
    }
}

__device__ __forceinline__ void load8_bf16(const bf16_t* p, float (&v)[8]) {
    const u32x4 w = *(const u32x4*)p;
    v[0] = bf_lo(w.x); v[1] = bf_hi(w.x); v[2] = bf_lo(w.y); v[3] = bf_hi(w.y); v[4] = bf_lo(w.z); v[5] = bf_hi(w.z); v[6] = bf_lo(w.w); v[7] = bf_hi(w.w);
}
__device__ __forceinline__ void load8_f32(const float* p, float (&v)[8]) {
    const f32x4 a = *(const f32x4*)p, b = *(const f32x4*)(p + 4);
    v[0] = a.x; v[1] = a.y; v[2] = a.z; v[3] = a.w; v[4] = b.x; v[5] = b.y; v[6] = b.z; v[7] = b.w;
}
__device__ __forceinline__ void store8_f32(float* p, const float (&v)[8]) {
    *(f32x4*)p = (f32x4){v[0], v[1], v[2], v[3]}; *(f32x4*)(p + 4) = (f32x4){v[4], v[5], v[6], v[7]};
}
__device__ __forceinline__ void phase_conv(const Args& a, LAS unsigned char* lds, int wave, int lane, int item0, int item_end, int item_step, unsigned* pub = nullptr) {
    const int tid = wave * 64 + lane;
    const float *state_a = a.in[2], *state_b = a.in[3], *conv_a_w = a.in[6], *conv_b_w = a.in[7], *conv_b_bias = a.in[8], *ln_g = a.in[9], *ln_b = a.in[10];
    const bf16_t* CV = (const bf16_t*)(a.ws + WS_CV); const bf16_t* BG = (const bf16_t*)(a.ws + WS_BG); const bf16_t* UB = (const bf16_t*)(a.ws + WS_UB);
    bf16_t* YM = (bf16_t*)(a.ws + WS_YM);
    LAS float* U = (LAS float*)lds; LAS float* CB = (LAS float*)(lds + CB_OFF);
    float wb[KB];
#pragma unroll
    for (int k = 0; k < KB; ++k) wb[k] = conv_b_w[k * GW + tid];
    const float bias = conv_b_bias[tid];
    const int c8 = (tid & 63) * 8, rsub = tid >> 6;
    for (int item = item0; item < item_end; item += item_step) {
        int T, row0, pos0, L, seq; bool smp;
        if (item < 512) { seq = item >> 6; T = 32; pos0 = (item & 63) * 32; row0 = seq * SEQ + pos0; L = SEQ; smp = false; }
        else { seq = item - 512; T = 8; pos0 = 0; row0 = NP + seq * DSEQ; L = DSEQ; smp = true; }
        float w0[8], w1[8], w2[8]; load8_f32(conv_a_w + c8, w0); load8_f32(conv_a_w + GW + c8, w1); load8_f32(conv_a_w + 2 * GW + c8, w2);
        if (!smp) {
            u32x4 raw[8], c0r[4], bgr[4], c1r[4], c2r[4]; const u32x4 zz = {0u, 0u, 0u, 0u};
#pragma unroll
            for (int p = 0; p < 8; ++p) { const int s = rsub + 8 * p, ts = pos0 - 30 + s; raw[p] = (s < 62 && ts >= 0) ? *(const u32x4*)(UB + (size_t)(row0 - 30 + s) * GW + c8) : zz; }
#pragma unroll
            for (int p = 0; p < 4; ++p) { const int t = rsub + 8 * p, pos = pos0 + t, row = row0 + t;
                c0r[p] = *(const u32x4*)(CV + (size_t)row * GW + c8); bgr[p] = *(const u32x4*)(BG + (size_t)row * GW + c8);
                c1r[p] = (pos >= 1) ? *(const u32x4*)(CV + (size_t)(row - 1) * GW + c8) : zz; c2r[p] = (pos >= 2) ? *(const u32x4*)(CV + (size_t)(row - 2) * GW + c8) : zz; }
#pragma unroll
            for (int p = 0; p < 8; ++p) { const int s = rsub + 8 * p; const u32x4 w = raw[p];
                if (s < 62) { *(LAS f32x4*)(U + s * GW + c8) = (f32x4){bf_lo(w.x), bf_hi(w.x), bf_lo(w.y), bf_hi(w.y)}; *(LAS f32x4*)(U + s * GW + c8 + 4) = (f32x4){bf_lo(w.z), bf_hi(w.z), bf_lo(w.w), bf_hi(w.w)}; } }
#pragma unroll
            for (int p = 0; p < 4; ++p) { const int t = rsub + 8 * p, pos = pos0 + t, row = row0 + t;
                const u32x4 a0 = c0r[p], a1 = c1r[p], a2 = c2r[p], bw = bgr[p];
                const float c0[8] = {bf_lo(a0.x), bf_hi(a0.x), bf_lo(a0.y), bf_hi(a0.y), bf_lo(a0.z), bf_hi(a0.z), bf_lo(a0.w), bf_hi(a0.w)};
                const float c1[8] = {bf_lo(a1.x), bf_hi(a1.x), bf_lo(a1.y), bf_hi(a1.y), bf_lo(a1.z), bf_hi(a1.z), bf_lo(a1.w), bf_hi(a1.w)};
                const float c2[8] = {bf_lo(a2.x), bf_hi(a2.x), bf_lo(a2.y), bf_hi(a2.y), bf_lo(a2.z), bf_hi(a2.z), bf_lo(a2.w), bf_hi(a2.w)};
                const float bg[8] = {bf_lo(bw.x), bf_hi(bw.x), bf_lo(bw.y), bf_hi(bw.y), bf_lo(bw.z), bf_hi(bw.z), bf_lo(bw.w), bf_hi(bw.w)};
                float y[8];
#pragma unroll
                for (int j = 0; j < 8; ++j) y[j] = bg[j] * (w0[j] * c2[j] + w1[j] * c1[j] + w2[j] * c0[j]);
                u32x4 w; w.x = cvt_pk_bf16(y[0], y[1]); w.y = cvt_pk_bf16(y[2], y[3]); w.z = cvt_pk_bf16(y[4], y[5]); w.w = cvt_pk_bf16(y[6], y[7]);
                if (pub) st16_wt(YM + (size_t)row * D + c8, w); else *(u32x4*)(YM + (size_t)row * D + c8) = w;
                if (pos >= L - 2) store8_f32(a.out + O_NAP + ((size_t)seq * 2 + (pos - (L - 2))) * GW + c8, c0); }
        } else {
        for (int s = rsub; s < T + 30; s += 8) { const int ts = pos0 - 30 + s; float v[8];
            if (ts >= 0) load8_bf16(UB + (size_t)(row0 - pos0 + ts) * GW + c8, v);
            else load8_f32(state_b + ((size_t)seq * 30 + (30 + ts)) * GW + c8, v);
            *(LAS f32x4*)(U + s * GW + c8) = (f32x4){v[0], v[1], v[2], v[3]}; *(LAS f32x4*)(U + s * GW + c8 + 4) = (f32x4){v[4], v[5], v[6], v[7]}; }
        { const int t = rsub; const int pos = pos0 + t, row = row0 + t; float c0[8], c1[8], c2[8], bg[8];
              load8_bf16(CV + (size_t)row * GW + c8, c0); load8_bf16(BG + (size_t)row * GW + c8, bg);
              if (pos >= 1) load8_bf16(CV + (size_t)(row - 1) * GW + c8, c1); else load8_f32(state_a + ((size_t)seq * 2 + 1) * GW + c8, c1);
              if (pos >= 2) load8_bf16(CV + (size_t)(row - 2) * GW + c8, c2); else load8_f32(state_a + ((size_t)seq * 2 + pos) * GW + c8, c2);
              float y[8];
#pragma unroll
              for (int j = 0; j < 8; ++j) y[j] = bg[j] * (w0[j] * c2[j] + w1[j] * c1[j] + w2[j] * c0[j]);
              u32x4 w; w.x = cvt_pk_bf16(y[0], y[1]); w.y = cvt_pk_bf16(y[2], y[3]); w.z = cvt_pk_bf16(y[4], y[5]); w.w = cvt_pk_bf16(y[6], y[7]);
              *(u32x4*)(YM + (size_t)row * D + c8) = w;
              if (pos >= L - 2) store8_f32(a.out + O_NAS + ((size_t)seq * 2 + (pos - (L - 2))) * GW + c8, c0); }
        }
        __syncthreads();
        for (int g = 0; g < T / 8; ++g) {
            float acc[8];
#pragma unroll
            for (int o = 0; o < 8; ++o) acc[o] = bias;
#pragma unroll
            for (int j = 0; j < 38; ++j) { const float v = U[(8 * g + j) * GW + tid];
#pragma unroll
                for (int o = 0; o < 8; ++o) { const int k = j - o; if (k >= 0 && k < KB) acc[o] += wb[k] * v; } }
#pragma unroll
            for (int o = 0; o < 8; ++o) CB[o * GW + tid] = acc[o];
            __syncthreads();
            { const f32x4 xa = *(const LAS f32x4*)(CB + wave * GW + lane * 8), xb = *(const LAS f32x4*)(CB + wave * GW + lane * 8 + 4);
              float x[8] = {xa.x, xa.y, xa.z, xa.w, xb.x, xb.y, xb.z, xb.w};
              float s = 0.f;
#pragma unroll
              for (int j = 0; j < 8; ++j) s += x[j];
              const float mean = wave_sum(s) * (1.f / GW); float q = 0.f;
#pragma unroll
              for (int j = 0; j < 8; ++j) { x[j] -= mean; q += x[j] * x[j]; }
              const float rstd = __builtin_amdgcn_rsqf(wave_sum(q) * (1.f / GW) + EPS);
              float gg[8], bb[8]; load8_f32(ln_g + lane * 8, gg); load8_f32(ln_b + lane * 8, bb);
              float y[8];
#pragma unroll
              for (int j = 0; j < 8; ++j) { const float z = x[j] * rstd * gg[j] + bb[j]; y[j] = z * sigmoidf_(z); }
              u32x4 w; w.x = cvt_pk_bf16(y[0], y[1]); w.y = cvt_pk_bf16(y[2], y[3]); w.z = cvt_pk_bf16(y[4], y[5]); w.w = cvt_pk_bf16(y[6], y[7]);
              if (pub && !smp) st16_wt(YM + (size_t)(row0 + 8 * g + wave) * D + GW + lane * 8, w); else *(u32x4*)(YM + (size_t)(row0 + 8 * g + wave) * D + GW + lane * 8) = w; }
            __syncthreads();
        }
        if (pos0 + T == L) {
            float* nb = a.out + (smp ? O_NBS : O_NBP) + (size_t)seq * 30 * GW;
            for (int i = rsub; i < 30; i += 8) { const f32x4 p = *(const LAS f32x4*)(U + (T + i) * GW + c8), q = *(const LAS f32x4*)(U + (T + i) * GW + c8 + 4);
                *(f32x4*)(nb + (size_t)i * GW + c8) = p; *(f32x4*)(nb + (size_t)i * GW + c8 + 4) = q; }
        }
        if (pub && !smp) { asm volatile("s_waitcnt vmcnt(0)" ::: "memory");
            if (lane == 0) __hip_atomic_fetch_add(pub + 32 * (row0 >> 8), 1u, __ATOMIC_RELAXED, __HIP_MEMORY_SCOPE_AGENT); }
        __syncthreads();
    }
}

__device__ __forceinline__ void phase_fixup(const Args& a, int wave, int lane) {
    const int gw = blockIdx.x * NWAVES + wave, NGW = gridDim.x * NWAVES;
    const bf16_t* SLAB = (const bf16_t*)(a.ws + WS_SLAB); bf16_t* X1B = (bf16_t*)(a.ws + WS_X1B); const float* SS1 = (const float*)(a.ws + WS_SS1); float* R1 = (float*)(a.ws + WS_R);
    for (int ms = gw; ms < NS; ms += NGW) {
        const int m = NP + ms; f32x4 v[4], p[4][4];
        const f32x4* xr = (const f32x4*)(a.in[1] + (size_t)ms * D) + lane;
#pragma unroll
        for (int j = 0; j < 4; ++j) v[j] = xr[64 * j];
#pragma unroll
        for (int ks = 0; ks < 4; ++ks) { const u32x2* sr = (const u32x2*)(SLAB + ((size_t)ks * NS + ms) * D) + lane;
#pragma unroll
            for (int j = 0; j < 4; ++j) { const u32x2 w = sr[64 * j]; p[ks][j] = (f32x4){bf_lo(w.x), bf_hi(w.x), bf_lo(w.y), bf_hi(w.y)}; } }
        float s = 0.f;
#pragma unroll
        for (int j = 0; j < 4; ++j) { v[j] += (p[0][j] + p[1][j]) + (p[2][j] + p[3][j]); s += (v[j].x * v[j].x + v[j].y * v[j].y) + (v[j].z * v[j].z + v[j].w * v[j].w); }
        s = wave_sum(s);
        u32x2* o8 = (u32x2*)(X1B + (size_t)m * D) + lane;
#pragma unroll
        for (int j = 0; j < 4; ++j) { u32x2 w; w.x = cvt_pk_bf16(v[j].x, v[j].y); w.y = cvt_pk_bf16(v[j].z, v[j].w); o8[64 * j] = w; }
        if (lane == 0) R1[m] = __builtin_amdgcn_rsqf(s * (1.f / D) + EPS);
    }
    for (int m = blockIdx.x * NTHREADS + threadIdx.x; m < NP; m += gridDim.x * NTHREADS) { const f32x4* sp = (const f32x4*)(SS1 + (size_t)m * 16);
        const f32x4 st = (sp[0] + sp[1]) + (sp[2] + sp[3]); R1[m] = __builtin_amdgcn_rsqf(((st[0] + st[1]) + (st[2] + st[3])) * (1.0f / D) + EPS); }
}

__device__ __forceinline__ void unpack_add(const u32x4 w, float (&v)[8], bool init) {
    const float t[8] = {bf_lo(w.x), bf_hi(w.x), bf_lo(w.y), bf_hi(w.y), bf_lo(w.z), bf_hi(w.z), bf_lo(w.w), bf_hi(w.w)};
#pragma unroll
    for (int j = 0; j < 8; ++j) v[j] = init ? t[j] : v[j] + t[j];
}
__device__ __forceinline__ void phase_final(const Args& a, LAS unsigned char* lds, int wave, int lane) {
    const float* g_final = a.in[16]; const bf16_t* SLAB = (const bf16_t*)(a.ws + WS_SLAB); const bf16_t* X1B = (const bf16_t*)(a.ws + WS_X1B);
    LAS float* red = (LAS float*)lds;
    const int rw = wave >> 1, hf = wave & 1, c0 = hf * 512 + lane * 8;
    float gf[8]; load8_f32(g_final + c0, gf);
    for (int ms0 = blockIdx.x * 4; ms0 < NS; ms0 += gridDim.x * 4) {
        const int ms = ms0 + rw, m = NP + ms;
        u32x4 raw[12];
        raw[0] = *(const u32x4*)(X1B + (size_t)m * D + c0);
#pragma unroll
        for (int ks = 0; ks < 11; ++ks) raw[1 + ks] = *(const u32x4*)(SLAB + ((size_t)ks * NS + ms) * D + c0);
        float v[8]; unpack_add(raw[0], v, true);
#pragma unroll
        for (int ks = 0; ks < 11; ++ks) unpack_add(raw[1 + ks], v, false);
        float s = 0.f;
#pragma unroll
        for (int j = 0; j < 8; ++j) s += v[j] * v[j];
        s = wave_sum(s);
        if (lane == 0) red[wave] = s;
        __syncthreads();
        const float r = __builtin_amdgcn_rsqf((red[rw * 2] + red[rw * 2 + 1]) * (1.f / D) + EPS);
        float* yr = a.out + O_Y + (size_t)m * D + c0;
        *(f32x4*)yr = (f32x4){v[0] * r * gf[0], v[1] * r * gf[1], v[2] * r * gf[2], v[3] * r * gf[3]};
        *(f32x4*)(yr + 4) = (f32x4){v[4] * r * gf[4], v[5] * r * gf[5], v[6] * r * gf[6], v[7] * r * gf[7]};
        __syncthreads();
    }
}

__device__ __forceinline__ int fresh_tid() { int t = threadIdx.x; asm volatile("" : "+v"(t)); return t; }
#define PHASE_IDS const int t_ = fresh_tid(); const int wave = __builtin_amdgcn_readfirstlane(t_ >> 6), lane = t_ & 63
__global__ void __launch_bounds__(NTHREADS, 2) fwd_megakernel(Args a) {
    extern __shared__ __attribute__((aligned(16))) unsigned char lds_raw[];
    LAS unsigned char* lds = (LAS unsigned char*)lds_raw;
    const int tid = threadIdx.x;
    volatile LAS unsigned* misc = (volatile LAS unsigned*)(lds + MISC_OFF);
    if (tid < 4) misc[tid] = 0u;
    __syncthreads();
    XcdBarrier bar = xcd_barrier_post((unsigned*)(a.ws + WS_CTL), misc);
    unsigned long long ts0 = 0, ts1 = 0, ts2 = 0, ts3 = 0, ts4 = 0, ts5 = 0, ts6 = 0, ts7 = 0;
#define STAMP(v) do { if (PROBE_T) v = __builtin_amdgcn_s_memrealtime(); } while (0)
    STAMP(ts0);

    { PHASE_IDS; phase0(a, lds, wave, lane); }
    xcd_barrier<false>(bar);
    STAMP(ts1);
    bool tailconv = false;
    {
        pg8::Gemm g{(const bf16_t*)(a.ws + WS_H), (const bf16_t*)(a.ws + WS_WIN), M, INC, D}; pg8::StaticOrder S; S.init(M, INC, D, gridDim.x, blockIdx.x, REP_GA);
        const int G = (int)gridDim.x, nlast = S.nwg % G, nidle = nlast ? G - nlast : 0; tailconv = nidle >= 32;
        S.rev = tailconv;
        EpiIn E{(bf16_t*)(a.ws + WS_CV), (bf16_t*)(a.ws + WS_BG), (bf16_t*)(a.ws + WS_UB), (const float*)(a.ws + WS_R0), (unsigned*)(a.ws + WS_CTL + CTL_SC), tailconv};
        pg8::gemm_phase<EpiIn, pg8::StaticOrder>(lds, g, S, E);
        { PHASE_IDS; if (tailconv) { if ((int)blockIdx.x >= nlast) { const int j = (int)blockIdx.x - nlast, n2 = (128 - nidle > 0 && 128 - nidle < nidle) ? 128 - nidle : 0;
                if (j >= n2) convert_weights<2>(a, lds, wave, lane, (j - n2) * NWAVES + wave, (nidle - n2) * NWAVES);
                if (t_ == 0) { unsigned sp = 0; const unsigned need = (unsigned)((M - NP) / 256 * (INC / 256) * NWAVES);
                    while (__hip_atomic_load(E.sc, __ATOMIC_RELAXED, __HIP_MEMORY_SCOPE_AGENT) < need) { __builtin_amdgcn_s_sleep(8); if (++sp > (1u << 20)) break; }
                    __builtin_amdgcn_fence(__ATOMIC_ACQUIRE, "agent"); asm volatile("s_waitcnt vmcnt(0)" ::: "memory"); }
                __syncthreads();
                phase_conv(a, lds, wave, lane, 512 + ((int)blockIdx.x - nlast), 640, nidle); } }
          else convert_weights<2>(a, lds, wave, lane, (int)blockIdx.x * NWAVES + wave, G * NWAVES); }
    }
    xcd_barrier<false>(bar);
    STAMP(ts2);
    unsigned* ymcnt = (unsigned*)(a.ws + WS_CTL + CTL_YM);
    { PHASE_IDS; phase_conv(a, lds, wave, lane, (int)blockIdx.x, tailconv ? 512 : 640, (int)gridDim.x, tailconv ? ymcnt : nullptr); }
    if (!tailconv) xcd_barrier<false>(bar);
    STAMP(ts3);
    {
        pg8::Gemm g{(const bf16_t*)(a.ws + WS_YM), (const bf16_t*)(a.ws + WS_WOUT), M, D, D}; pg8::SplitOrder S; S.init(NP, M, D, D, gridDim.x, blockIdx.x);
        EpiOut E{(const bf16_t*)(a.ws + WS_H), (bf16_t*)(a.ws + WS_X1B), (float*)(a.ws + WS_SS1), (bf16_t*)(a.ws + WS_SLAB)};
        if (tailconv) { pg8::Unit u0;
            if (S.next(0, u0) && u0.pm < NP / 256 && tid == 0) { unsigned sp = 0;
                while (__hip_atomic_load(ymcnt + 32 * u0.pm, __ATOMIC_RELAXED, __HIP_MEMORY_SCOPE_AGENT) < 64u) { __builtin_amdgcn_s_sleep(2); if (++sp > (1u << 20)) break; } }
            __syncthreads(); }
        pg8::gemm_phase<EpiOut, pg8::SplitOrder>(lds, g, S, E);
        { PHASE_IDS; const int nidle = (int)gridDim.x - S.nsub; if (nidle >= 64) { if ((int)blockIdx.x >= S.nsub) convert_weights<1>(a, lds, wave, lane, ((int)blockIdx.x - S.nsub) * NWAVES + wave, nidle * NWAVES); }
          else convert_weights<1>(a, lds, wave, lane, (int)blockIdx.x * NWAVES + wave, (int)gridDim.x * NWAVES); }
    }
    xcd_barrier<false>(bar);
    STAMP(ts4);
    { PHASE_IDS; phase_fixup(a, wave, lane); }
    xcd_barrier<false>(bar);
    {
        pg8::Gemm g{(const bf16_t*)(a.ws + WS_X1B), (const bf16_t*)(a.ws + WS_WGU), M, GU, D}; pg8::StaticOrder S; S.init(M, GU, D, gridDim.x, blockIdx.x, REP_GD);
        EpiGU E{(const float*)(a.ws + WS_R), (bf16_t*)(a.ws + WS_F)};
        pg8::gemm_phase<EpiGU, pg8::StaticOrder>(lds, g, S, E);
    }
    xcd_barrier<true>(bar);
    STAMP(ts5);
    {
        pg8::Gemm g{(const bf16_t*)(a.ws + WS_F), (const bf16_t*)(a.ws + WS_WDN), M, D, FF}; pg8::SplitOrder S; S.init(NP, M, D, FF, gridDim.x, blockIdx.x);
        EpiDown E{(const bf16_t*)(a.ws + WS_X1B), a.out + O_Y, (bf16_t*)(a.ws + WS_SLAB), (float*)(a.ws + WS_XS), (unsigned*)(a.ws + WS_CTL + CTL_CNT), a.in[16]};
        pg8::gemm_phase<EpiDown, pg8::SplitOrder>(lds, g, S, E);
    }
    xcd_barrier<true>(bar);
    STAMP(ts6);
    { PHASE_IDS; phase_final(a, lds, wave, lane); }
    if (PROBE_T) {
        asm volatile("s_waitcnt vmcnt(0)" ::: "memory"); __syncthreads();
        STAMP(ts7);
        if (blockIdx.x == 0 && tid == 0) {
            const unsigned long long C[8] = {0, ts1 - ts0, ts2 - ts0, ts3 - ts0, ts4 - ts0, ts5 - ts0, ts6 - ts0, ts7 - ts0};
            const unsigned long long d = 16ull * C[PROBE_T1];
            while (__builtin_amdgcn_s_memrealtime() - ts7 < d) __builtin_amdgcn_s_sleep(32);
        }
    }
}

extern "C" void kernel_launch(void* const* d_in, const int* in_sizes, int n_in, void* d_out, int out_size, void* d_ws, size_t ws_size, hipStream_t stream) {
    static int grid = 0;
    if (grid == 0) {
        if (n_in != 17 || ws_size < WS_END) { fprintf(stderr, "kernel_launch: unexpected n_in %d / ws %zu\n", n_in, ws_size); grid = -1; return; }
        int dev = 0, cus = 0, per_cu = 0;
        if (hipGetDevice(&dev) != hipSuccess || hipDeviceGetAttribute(&cus, hipDeviceAttributeMultiprocessorCount, dev) != hipSuccess) { grid = -1; return; }
        if (hipFuncSetAttribute((const void*)fwd_megakernel, hipFuncAttributeMaxDynamicSharedMemorySize, LDS_BYTES) != hipSuccess) { fprintf(stderr, "kernel_launch: hipFuncSetAttribute failed\n"); grid = -1; return; }
        if (hipOccupancyMaxActiveBlocksPerMultiprocessor(&per_cu, (const void*)fwd_megakernel, NTHREADS, LDS_BYTES) != hipSuccess || per_cu < 1) { fprintf(stderr, "kernel_launch: occupancy query says %d blocks per CU\n", per_cu); grid = -1; (void)hipGetLastError(); return; }
        grid = cus;
    }
    if (grid < 0) return;
    (void)hipMemsetAsync((char*)d_ws + WS_CTL, 0, CTL_BYTES, stream);
    Args a{};
    for (int i = 0; i < 17; ++i) a.in[i] = (const float*)d_in[i];
    a.out = (float*)d_out; a.ws = (unsigned char*)d_ws;
    hipLaunchKernelGGL(fwd_megakernel, dim3(grid), dim3(NTHREADS), LDS_BYTES, stream, a);
}
```
